# Optimizing an MI355X kernel written in HIP

```python
import math
import jax, jax.numpy as jnp
from jax import lax
import numpy as np

D_MODEL = 2048
BATCH = 4
SEQ = 2048
DEPTH = 4

CHUNK = 64
D_MIX = D_MODEL
D_S5 = D_MIX // 2
D_CONV = D_MIX - D_S5
S5_P = 16
S5_G = D_S5 // S5_P
S5_N = 64
CONV_HEADS = 8
CONV_W = 3
D_IN = D_S5 + 3 * D_CONV
D_FF = 5632
LN_EPS = 1e-5
RMS_EPS = 1e-6
DEEPNORM_ALPHA = (2.0 * DEPTH) ** 0.25
DEEPNORM_BETA = (8.0 * DEPTH) ** -0.25

kernel_name = "hybrid_s5_shortconv_macaron_deepnorm"


def layer_norm(x, g, b):
    xf = x.astype(jnp.float32)
    mu = jnp.mean(xf, axis=-1, keepdims=True)
    xc = xf - mu
    var = jnp.mean(xc * xc, axis=-1, keepdims=True)
    y = xc * lax.rsqrt(var + LN_EPS)
    return (y * g.astype(jnp.float32) + b.astype(jnp.float32)).astype(x.dtype)


def rms_norm(x, g):
    xf = x.astype(jnp.float32)
    y = xf * lax.rsqrt(jnp.mean(xf * xf, axis=-1, keepdims=True) + RMS_EPS)
    return (y * g.astype(jnp.float32)).astype(x.dtype)


def swiglu(x, w_gate, w_up, w_down):
    return (jax.nn.silu(x @ w_gate) * (x @ w_up)) @ w_down


def s5_mixer(u, lam_re, lam_im, log_dt, b_re, b_im, c_re, c_im, d):
    bsz, seq, _ = u.shape
    f32 = jnp.float32
    uf = u.astype(f32).reshape(bsz, seq, S5_G, S5_P)
    lre = lam_re.astype(f32)
    lim = lam_im.astype(f32)
    dt = jnp.exp(log_dt.astype(f32))[:, None]
    mag = jnp.exp(lre * dt)
    ang = lim * dt
    ab_re = mag * jnp.cos(ang)
    ab_im = mag * jnp.sin(ang)
    den = lre * lre + lim * lim
    nr = ab_re - 1.0
    ni = ab_im
    q_re = (nr * lre + ni * lim) / den
    q_im = (ni * lre - nr * lim) / den
    br = b_re.astype(f32)
    bi = b_im.astype(f32)
    bb_re = q_re[..., None] * br - q_im[..., None] * bi
    bb_im = q_re[..., None] * bi + q_im[..., None] * br
    bu_re = jnp.einsum('blgp,gnp->blgn', uf, bb_re)
    bu_im = jnp.einsum('blgp,gnp->blgn', uf, bb_im)
    a_re = jnp.broadcast_to(ab_re, bu_re.shape)
    a_im = jnp.broadcast_to(ab_im, bu_im.shape)

    def combine(e1, e2):
        a1r, a1i, b1r, b1i = e1
        a2r, a2i, b2r, b2i = e2
        return (a1r * a2r - a1i * a2i,
                a1r * a2i + a1i * a2r,
                a2r * b1r - a2i * b1i + b2r,
                a2r * b1i + a2i * b1r + b2i)

    _, _, s_re, s_im = lax.associative_scan(combine, (a_re, a_im, bu_re, bu_im), axis=1)
    y = (jnp.einsum('blgn,gpn->blgp', s_re, c_re.astype(f32))
         - jnp.einsum('blgn,gpn->blgp', s_im, c_im.astype(f32))
         + d.astype(f32) * uf)
    return y.reshape(bsz, seq, S5_G * S5_P).astype(u.dtype)


def causal_depthwise_conv(z, w, b):
    seq = z.shape[1]
    zp = jnp.pad(z, ((0, 0), (CONV_W - 1, 0), (0, 0)))
    out = b
    for k in range(CONV_W):
        out = out + w[k] * zp[:, k:k + seq]
    return out


def hybrid_mixer(x, w_in, lam_re, lam_im, log_dt, b_re, b_im, c_re, c_im, d,
                 w_glu, conv_w, conv_b, g_s5, g_conv, w_out):
    proj = x @ w_in
    u = proj[..., :D_S5]
    gate_b = proj[..., D_S5:D_S5 + D_CONV]
    gate_c = proj[..., D_S5 + D_CONV:D_S5 + 2 * D_CONV]
    h = proj[..., D_S5 + 2 * D_CONV:]
    y = jax.nn.gelu(s5_mixer(u, lam_re, lam_im, log_dt, b_re, b_im, c_re, c_im, d))
    y = y * jax.nn.sigmoid(y @ w_glu)
    y = rms_norm(y, g_s5)
    z = gate_b * causal_depthwise_conv(gate_c * h, conv_w, conv_b)
    z = rms_norm(z, g_conv)
    return jnp.concatenate([y, z], axis=-1) @ w_out


def setup_inputs(seed: int = 0) -> dict:
    key = jax.random.key(seed)
    ks = jax.random.split(key, 32)
    f32 = jnp.float32

    def nrm(k, shape, scale):
        return jax.random.normal(k, shape, f32) * scale

    def gain(k, shape):
        return 1.0 + 0.02 * jax.random.normal(k, shape, f32)

    L = DEPTH
    n_idx = jnp.arange(S5_N, dtype=f32)
    inp = {}
    inp["x"] = jax.random.normal(ks[0], (BATCH, SEQ, D_MODEL), f32)
    inp["ffn1_gate"] = nrm(ks[1], (L, D_MODEL, D_FF), D_MODEL ** -0.5)
    inp["ffn1_up"] = nrm(ks[2], (L, D_MODEL, D_FF), D_MODEL ** -0.5)
    inp["ffn1_down"] = nrm(ks[3], (L, D_FF, D_MODEL), D_FF ** -0.5 * DEEPNORM_BETA)
    inp["ln1_g"] = gain(ks[4], (L, D_MODEL))
    inp["ln1_b"] = nrm(ks[5], (L, D_MODEL), 0.02)
    inp["w_in"] = nrm(ks[6], (L, D_MODEL, D_IN), D_MODEL ** -0.5)
    inp["s5_lam_re"] = -0.5 * jnp.exp(0.05 * jax.random.normal(ks[7], (L, S5_G, S5_N), f32))
    inp["s5_lam_im"] = math.pi * n_idx + 0.01 * jax.random.normal(ks[8], (L, S5_G, S5_N), f32)
    inp["s5_log_dt"] = jax.random.uniform(ks[9], (L, S5_G), f32, math.log(1e-3), math.log(1e-1))
    inp["s5_b_re"] = nrm(ks[10], (L, S5_G, S5_N, S5_P), (2.0 * S5_P) ** -0.5)
    inp["s5_b_im"] = nrm(ks[11], (L, S5_G, S5_N, S5_P), (2.0 * S5_P) ** -0.5)
    inp["s5_c_re"] = nrm(ks[12], (L, S5_G, S5_P, S5_N), (2.0 * S5_N) ** -0.5)
    inp["s5_c_im"] = nrm(ks[13], (L, S5_G, S5_P, S5_N), (2.0 * S5_N) ** -0.5)
    inp["s5_d"] = nrm(ks[14], (L, S5_G, S5_P), 1.0)
    inp["s5_w_glu"] = nrm(ks[15], (L, D_S5, D_S5), D_S5 ** -0.5)
    inp["conv_w"] = nrm(ks[16], (L, CONV_W, D_CONV), CONV_W ** -0.5)
    inp["conv_b"] = nrm(ks[17], (L, D_CONV), 0.02)
    inp["g_s5"] = gain(ks[18], (L, D_S5))
    inp["g_conv"] = gain(ks[19], (L, D_CONV))
    inp["w_out"] = nrm(ks[20], (L, D_MIX, D_MODEL), D_MIX ** -0.5 * DEEPNORM_BETA)
    inp["ln2_g"] = gain(ks[21], (L, D_MODEL))
    inp["ln2_b"] = nrm(ks[22], (L, D_MODEL), 0.02)
    inp["ffn2_gate"] = nrm(ks[23], (L, D_MODEL, D_FF), D_MODEL ** -0.5)
    inp["ffn2_up"] = nrm(ks[24], (L, D_MODEL, D_FF), D_MODEL ** -0.5)
    inp["ffn2_down"] = nrm(ks[25], (L, D_FF, D_MODEL), D_FF ** -0.5 * DEEPNORM_BETA)
    inp["ln3_g"] = gain(ks[26], (L, D_MODEL))
    inp["ln3_b"] = nrm(ks[27], (L, D_MODEL), 0.02)
    return inp


def reference(x, ffn1_gate, ffn1_up, ffn1_down, ln1_g, ln1_b, w_in, s5_lam_re, s5_lam_im,
              s5_log_dt, s5_b_re, s5_b_im, s5_c_re, s5_c_im, s5_d, s5_w_glu, conv_w, conv_b,
              g_s5, g_conv, w_out, ln2_g, ln2_b, ffn2_gate, ffn2_up, ffn2_down, ln3_g, ln3_b):
    for l in range(DEPTH):
        x = layer_norm(DEEPNORM_ALPHA * x + 0.5 * swiglu(x, ffn1_gate[l], ffn1_up[l], ffn1_down[l]),
                       ln1_g[l], ln1_b[l])
        m = hybrid_mixer(x, w_in[l], s5_lam_re[l], s5_lam_im[l], s5_log_dt[l], s5_b_re[l],
                         s5_b_im[l], s5_c_re[l], s5_c_im[l], s5_d[l], s5_w_glu[l], conv_w[l],
                         conv_b[l], g_s5[l], g_conv[l], w_out[l])
        x = layer_norm(DEEPNORM_ALPHA * x + m, ln2_g[l], ln2_b[l])
        x = layer_norm(DEEPNORM_ALPHA * x + 0.5 * swiglu(x, ffn2_gate[l], ffn2_up[l], ffn2_down[l]),
                       ln3_g[l], ln3_b[l])
    return x
```

```cpp
#include <hip/hip_runtime.h>
#include <cstdio>
#include <cstdint>
namespace pg8 {
#define PG8_LAS __attribute__((address_space(3)))
typedef unsigned short bf16_t;
typedef short bf16x8 __attribute__((ext_vector_type(8)));
typedef float f32x4 __attribute__((ext_vector_type(4)));
typedef unsigned u32x4 __attribute__((ext_vector_type(4)));
constexpr int BM = 256, BK = 64, HALF = 128, HTB = HALF * BK * 2  , STAGE_BYTES = 8 * HTB, NXCD = 8, WGM = 8;

__host__ __device__ __forceinline__ int lds_byte(int r, int c) { const int st = (r >> 4) * 2 + (c >> 5), rr = r & 15, cc = c & 31, ob = rr * 64 + cc * 2; return st * 1024 + (ob ^ (((ob >> 9) & 1) << 5)); }
__host__ __device__ __forceinline__ void stage_rc(int b, int& R, int& C) { const int st = b / 1024, sb = b % 1024, swz = sb ^ (((sb >> 9) & 1) << 5); R = (st >> 1) * 16 + swz / 64; C = (st & 1) * 32 + (swz % 64) / 2; }
__host__ __device__ __forceinline__ int perm32(int rho) { const int n = rho >> 4, i = rho & 15; return 8 * (i >> 2) + 4 * n + (i & 3); }

struct Unit { int pm, pn; };
struct Gemm { const bf16_t* A; const bf16_t* Bt; int M, N, K; };

struct StaticOrder {
    int nM, nN, nwg, G, c;
    __host__ __device__ void init(int M, int N, int G_, int c_) { nM = M / BM; nN = N / BM; nwg = nM * nN; G = G_; c = c_; }
    __host__ __device__ bool next(int i, Unit& u) const {
        const long L = (long)i * G + c; if (L >= nwg) return false;
        int wgid = (int)L; { const int q = nwg / NXCD, r = nwg % NXCD, xcd = wgid % NXCD, off = wgid / NXCD; wgid = (xcd < r ? xcd * (q + 1) : r * (q + 1) + (xcd - r) * q) + off; }
        const int nig = WGM * nN, gid = wgid / nig, fm = gid * WGM, gsz = (nM - fm) < WGM ? (nM - fm) : WGM;
        u.pm = fm + ((wgid % nig) % gsz); u.pn = (wgid % nig) / gsz; return true;
    }
    __device__ __forceinline__ void a_ready(const Unit&) const {}
    __device__ __forceinline__ void done(const Unit&) const {}
};

__device__ __forceinline__ unsigned cvt_pk_bf16(float lo, float hi) { unsigned r; asm volatile("v_cvt_pk_bf16_f32 %0, %1, %2" : "=v"(r) : "v"(lo), "v"(hi)); return r; }
typedef float f32x2 __attribute__((ext_vector_type(2)));
__device__ __forceinline__ float sigmoid_f(float x) { return __builtin_amdgcn_rcpf(1.0f + __builtin_amdgcn_exp2f(x * -1.4426950408889634f)); }
__device__ __forceinline__ float bf2f(unsigned short h) { return __uint_as_float(((unsigned)h) << 16); }
struct EpiSwiglu {
    static constexpr bool PERM = true, AFTER_DRAIN = false;
    bf16_t* H; int ldh;
    __device__ __forceinline__ void operator()(const f32x4 (&acc)[2][2][4][2], const Unit& u, int wr, int wc, int fr, int fq) const {
        const int row0 = u.pm * BM + wr * 64 + fr, col0 = u.pn * HALF + wc * 32 + 8 * fq;
#pragma unroll
        for (int ai = 0; ai < 2; ++ai)
#pragma unroll
            for (int m = 0; m < 4; ++m) { bf16_t* p = H + (size_t)(row0 + ai * HALF + m * 16) * ldh + col0;
                float o[8];
#pragma unroll
                for (int n = 0; n < 2; ++n)
#pragma unroll
                    for (int e = 0; e < 4; ++e) { const float g = acc[ai][0][m][n][e], up = acc[ai][1][m][n][e]; o[n * 4 + e] = g * sigmoid_f(g) * up; }
                u32x4 w; w.x = cvt_pk_bf16(o[0], o[1]); w.y = cvt_pk_bf16(o[2], o[3]); w.z = cvt_pk_bf16(o[4], o[5]); w.w = cvt_pk_bf16(o[6], o[7]);
                *(u32x4*)p = w; }
    }
};
struct EpiResF32 {
    static constexpr bool PERM = false, AFTER_DRAIN = false;
    const float* R; float* V; int ldc; float alpha, scale;
    __device__ __forceinline__ void operator()(const f32x4 (&acc)[2][2][4][2], const Unit& u, int wr, int wc, int fr, int fq) const {
        const int row0 = u.pm * BM + wr * 64 + fr, col0 = u.pn * BM + wc * 32 + 4 * fq;
#pragma unroll
        for (int ai = 0; ai < 2; ++ai)
#pragma unroll
            for (int m = 0; m < 4; ++m) { const size_t off = (size_t)(row0 + ai * HALF + m * 16) * ldc + col0;
#pragma unroll
                for (int bj = 0; bj < 2; ++bj)
#pragma unroll
                    for (int n = 0; n < 2; ++n) { const f32x4 r = *(const f32x4*)(R + off + bj * HALF + n * 16);
                        *(f32x4*)(V + off + bj * HALF + n * 16) = r * alpha + acc[ai][bj][m][n] * scale; } }
    }
};
struct EpiProj {
    static constexpr bool PERM = true, AFTER_DRAIN = false;
    bf16_t* U; bf16_t* GB;
    __device__ __forceinline__ void operator()(const f32x4 (&acc)[2][2][4][2], const Unit& u, int wr, int wc, int fr, int fq) const {
        const int row0 = u.pm * BM + wr * 64 + fr;
#pragma unroll
        for (int ai = 0; ai < 2; ++ai)
#pragma unroll
            for (int m = 0; m < 4; ++m) { const int row = row0 + ai * HALF + m * 16;
#pragma unroll
                for (int bj = 0; bj < 2; ++bj) { const int col = u.pn * BM + bj * HALF + wc * 32 + 8 * fq;
                    const f32x4 v0 = acc[ai][bj][m][0], v1 = acc[ai][bj][m][1];
                    u32x4 w; w.x = cvt_pk_bf16(v0[0], v0[1]); w.y = cvt_pk_bf16(v0[2], v0[3]); w.z = cvt_pk_bf16(v1[0], v1[1]); w.w = cvt_pk_bf16(v1[2], v1[3]);
                    bf16_t* p;
                    if (u.pn < 4) { const int b = row >> 11, l = row & 2047, g = col >> 4, p0 = col & 15; p = U + ((size_t)((b * 64 + g) * 2048 + l)) * 16 + p0; }
                    else p = GB + (size_t)row * 3072 + (col - 1024);
                    *(u32x4*)p = w; } }
    }
};
struct EpiGlu {
    static constexpr bool PERM = true, AFTER_DRAIN = false;
    const bf16_t* Y; bf16_t* YG; int ld;
    __device__ __forceinline__ void operator()(const f32x4 (&acc)[2][2][4][2], const Unit& u, int wr, int wc, int fr, int fq) const {
        const int row0 = u.pm * BM + wr * 64 + fr;
#pragma unroll
        for (int ai = 0; ai < 2; ++ai)
#pragma unroll
            for (int m = 0; m < 4; ++m) { const int row = row0 + ai * HALF + m * 16;
#pragma unroll
                for (int bj = 0; bj < 2; ++bj) { const size_t off = (size_t)row * ld + u.pn * BM + bj * HALF + wc * 32 + 8 * fq;
                    const u32x4 yv = *(const u32x4*)(Y + off);
                    const f32x4 v0 = acc[ai][bj][m][0], v1 = acc[ai][bj][m][1];
                    float o[8];
                    o[0] = __uint_as_float(yv.x << 16) * sigmoid_f(v0[0]); o[1] = __uint_as_float(yv.x & 0xffff0000u) * sigmoid_f(v0[1]);
                    o[2] = __uint_as_float(yv.y << 16) * sigmoid_f(v0[2]); o[3] = __uint_as_float(yv.y & 0xffff0000u) * sigmoid_f(v0[3]);
                    o[4] = __uint_as_float(yv.z << 16) * sigmoid_f(v1[0]); o[5] = __uint_as_float(yv.z & 0xffff0000u) * sigmoid_f(v1[1]);
                    o[6] = __uint_as_float(yv.w << 16) * sigmoid_f(v1[2]); o[7] = __uint_as_float(yv.w & 0xffff0000u) * sigmoid_f(v1[3]);
                    u32x4 w; w.x = cvt_pk_bf16(o[0], o[1]); w.y = cvt_pk_bf16(o[2], o[3]); w.z = cvt_pk_bf16(o[4], o[5]); w.w = cvt_pk_bf16(o[6], o[7]);
                    *(u32x4*)(YG + off) = w; } }
    }
};

template <class Epi, class Sched, bool ALIGN_EPI = false, bool SP2 = false>
__device__ __forceinline__ void gemm_phase(PG8_LAS unsigned char* lds, const Gemm g, const Sched& S, const Epi& E, const int wid_in  ) {
    int m1_ = -1; asm volatile("" : "+s"(m1_)); int tid_ = wid_in * 64 + (int)__builtin_amdgcn_mbcnt_hi((unsigned)m1_, __builtin_amdgcn_mbcnt_lo((unsigned)m1_, 0u)); asm volatile("" : "+v"(tid_));
    const int tid = tid_, wid = __builtin_amdgcn_readfirstlane(tid >> 6), lane = tid & 63, wr = wid >> 2, wc = wid & 3, fr = lane & 15, fq = lane >> 4;
    int K_ = g.K; asm volatile("" : "+s"(K_));
    const int K = K_, nt = K / BK;
    unsigned voffA[2], voffB[2];
#pragma unroll
    for (int i = 0; i < 2; ++i) { int R, C; stage_rc(tid * 16 + i * 8192, R, C); const int Rb = Epi::PERM ? ((R & ~31) + perm32(R & 31)) : R;
        voffA[i] = (unsigned)(R * K + C) * 2u; voffB[i] = (unsigned)(Rb * K + C) * 2u; }
    const size_t kstep = (size_t)(BK * 2);
    const size_t hstep = (size_t)HALF * K * 2;
    const size_t tstep = 2 * hstep;
    const unsigned ldsw = (unsigned)wid * 1024u;
    const int aoff = lds_byte(wr * 64 + fr, fq * 8), boff = lds_byte(wc * 32 + fr, fq * 8);
#define PG8_SA(b, h) (((b) * 2 + (h)) * HTB)
#define PG8_SB(b, h) ((4 + (b) * 2 + (h)) * HTB)
#define PG8_STAGE(bufoff, gbase, voff) do { _Pragma("unroll") for (int _i = 0; _i < 2; ++_i) \
        __builtin_amdgcn_global_load_lds((const unsigned*)((const char*)(gbase) + (voff)[_i]), (PG8_LAS unsigned*)(lds + (bufoff) + ldsw + _i * 8192), 16, 0, 0); } while (0)
#define PG8_LDA(dst, b, h) do { _Pragma("unroll") for (int m = 0; m < 4; ++m) _Pragma("unroll") for (int k = 0; k < 2; ++k) dst[m][k] = *(const PG8_LAS bf16x8*)(lds + PG8_SA(b, h) + aoff + m * 2048 + k * 1024); } while (0)
#define PG8_LDB(dst, b, h) do { _Pragma("unroll") for (int n = 0; n < 2; ++n) _Pragma("unroll") for (int k = 0; k < 2; ++k) dst[n][k] = *(const PG8_LAS bf16x8*)(lds + PG8_SB(b, h) + boff + n * 2048 + k * 1024); } while (0)
#define PG8_MMA(ai, bj, At, Bt) do { __builtin_amdgcn_s_setprio(1); _Pragma("unroll") for (int m = 0; m < 4; ++m) _Pragma("unroll") for (int n = 0; n < 2; ++n) _Pragma("unroll") for (int k = 0; k < 2; ++k) \
        acc[ai][bj][m][n] = __builtin_amdgcn_mfma_f32_16x16x32_bf16(Bt[n][k], At[m][k], acc[ai][bj][m][n], 0, 0, 0); __builtin_amdgcn_s_setprio(0); } while (0)
#define PG8_WAIT_V(n) asm volatile("s_waitcnt vmcnt(" #n ")" ::: "memory")
#define PG8_WAIT_L(n) asm volatile("s_waitcnt lgkmcnt(" #n ")" ::: "memory")
#define PG8_BAR __builtin_amdgcn_s_barrier()
#define PG8_SCHED __builtin_amdgcn_sched_barrier(0)
    Unit cur, nxt; int ui = 0;
    if (!S.next(0, cur)) return;
    f32x4 acc[2][2][4][2];
#pragma unroll
    for (int a = 0; a < 2; ++a)
#pragma unroll
        for (int b = 0; b < 2; ++b)
#pragma unroll
            for (int m = 0; m < 4; ++m)
#pragma unroll
                for (int n = 0; n < 2; ++n) acc[a][b][m][n] = (f32x4){0.f, 0.f, 0.f, 0.f};
    bf16x8 At[4][2], B0[2][2], B1[2][2];
    const char* cA = (const char*)g.A + (size_t)cur.pm * tstep; const char* cB = (const char*)g.Bt + (size_t)cur.pn * tstep;
    S.a_ready(cur);
    if constexpr (SP2) {
        PG8_STAGE(PG8_SB(0, 0), cB, voffB); PG8_STAGE(PG8_SB(0, 1), cB + hstep, voffB); PG8_STAGE(PG8_SA(0, 0), cA, voffA); PG8_STAGE(PG8_SA(0, 1), cA + hstep, voffA);
        if (wr == 1) PG8_BAR;
        PG8_WAIT_V(2); PG8_BAR;
        PG8_STAGE(PG8_SB(1, 0), cB + kstep, voffB); PG8_STAGE(PG8_SA(1, 0), cA + kstep, voffA); PG8_STAGE(PG8_SB(1, 1), cB + hstep + kstep, voffB);
        PG8_WAIT_V(6); PG8_BAR;
    } else {
        PG8_STAGE(PG8_SB(0, 0), cB, voffB); PG8_STAGE(PG8_SA(0, 0), cA, voffA); PG8_STAGE(PG8_SB(0, 1), cB + hstep, voffB); PG8_STAGE(PG8_SA(0, 1), cA + hstep, voffA);
        if (wr == 1) PG8_BAR;
        PG8_WAIT_V(4); PG8_BAR;
        PG8_STAGE(PG8_SB(1, 0), cB + kstep, voffB); PG8_STAGE(PG8_SA(1, 0), cA + kstep, voffA); PG8_STAGE(PG8_SB(1, 1), cB + hstep + kstep, voffB);
        PG8_WAIT_V(6); PG8_BAR;
    }
    for (;;) {
        const bool has_next = S.next(ui + 1, nxt);
        const char* nA = has_next ? (const char*)g.A + (size_t)nxt.pm * tstep : cA; const char* nB = has_next ? (const char*)g.Bt + (size_t)nxt.pn * tstep : cB;
        for (int t = 0; t < nt; t += 2) {
            const bool last = (t == nt - 2);
            const char* a1 = cA + (size_t)(t + 1) * kstep;
            const char* a2 = last ? nA : cA + (size_t)(t + 2) * kstep; const char* b2 = last ? nB : cB + (size_t)(t + 2) * kstep;
            const char* a3 = a2 + kstep; const char* b3 = b2 + kstep;
            if (last && has_next) S.a_ready(nxt);
            if constexpr (SP2) {
            PG8_LDB(B0, 0, 0); PG8_LDB(B1, 0, 1); PG8_SCHED; PG8_LDA(At, 0, 0); PG8_STAGE(PG8_SA(1, 1), a1 + hstep, voffA);
            PG8_WAIT_V(8); PG8_WAIT_L(0); PG8_BAR; PG8_MMA(0, 0, At, B0); PG8_MMA(0, 1, At, B1); PG8_BAR; PG8_SCHED;
            PG8_LDA(At, 0, 1); PG8_STAGE(PG8_SB(0, 0), b2, voffB); PG8_STAGE(PG8_SB(0, 1), b2 + hstep, voffB); PG8_STAGE(PG8_SA(0, 0), a2, voffA);
            PG8_WAIT_V(8); PG8_WAIT_L(0); PG8_BAR; PG8_MMA(1, 0, At, B0); PG8_MMA(1, 1, At, B1); PG8_BAR; PG8_SCHED;
            PG8_LDB(B0, 1, 0); PG8_LDB(B1, 1, 1); PG8_SCHED; PG8_LDA(At, 1, 0); PG8_STAGE(PG8_SA(0, 1), a2 + hstep, voffA);
            PG8_WAIT_V(8); PG8_WAIT_L(0); PG8_BAR; PG8_MMA(0, 0, At, B0); PG8_MMA(0, 1, At, B1); PG8_BAR; PG8_SCHED;
            PG8_LDA(At, 1, 1); PG8_STAGE(PG8_SB(1, 0), b3, voffB); PG8_STAGE(PG8_SB(1, 1), b3 + hstep, voffB); PG8_STAGE(PG8_SA(1, 0), a3, voffA);
            PG8_WAIT_V(8); PG8_WAIT_L(0); PG8_BAR; PG8_MMA(1, 0, At, B0); PG8_MMA(1, 1, At, B1); PG8_BAR; PG8_SCHED;
            } else {
            PG8_LDB(B0, 0, 0); PG8_SCHED; PG8_LDA(At, 0, 0); PG8_STAGE(PG8_SA(1, 1), a1 + hstep, voffA);
            PG8_WAIT_L(8); PG8_BAR; PG8_WAIT_L(0); PG8_MMA(0, 0, At, B0); PG8_BAR; PG8_SCHED;
            PG8_LDB(B1, 0, 1); PG8_STAGE(PG8_SB(0, 0), b2, voffB);
            PG8_BAR; PG8_WAIT_L(0); PG8_MMA(0, 1, At, B1); PG8_BAR;
            PG8_LDA(At, 0, 1); PG8_STAGE(PG8_SA(0, 0), a2, voffA);
            PG8_BAR; PG8_WAIT_L(0); PG8_MMA(1, 0, At, B0); PG8_BAR; PG8_SCHED;
            PG8_STAGE(PG8_SB(0, 1), b2 + hstep, voffB);
            PG8_WAIT_V(6); PG8_BAR; PG8_MMA(1, 1, At, B1); PG8_BAR;
            PG8_LDB(B0, 1, 0); PG8_SCHED; PG8_LDA(At, 1, 0); PG8_STAGE(PG8_SA(0, 1), a2 + hstep, voffA);
            PG8_WAIT_L(8); PG8_BAR; PG8_WAIT_L(0); PG8_MMA(0, 0, At, B0); PG8_BAR; PG8_SCHED;
            PG8_LDB(B1, 1, 1); PG8_STAGE(PG8_SB(1, 0), b3, voffB);
            PG8_BAR; PG8_WAIT_L(0); PG8_MMA(0, 1, At, B1); PG8_BAR;
            PG8_LDA(At, 1, 1); PG8_STAGE(PG8_SA(1, 0), a3, voffA);
            PG8_BAR; PG8_WAIT_L(0); PG8_MMA(1, 0, At, B0); PG8_BAR; PG8_SCHED;
            PG8_STAGE(PG8_SB(1, 1), b3 + hstep, voffB);
            PG8_WAIT_V(6); PG8_BAR; PG8_MMA(1, 1, At, B1); PG8_BAR;
            }
        }
        if constexpr (ALIGN_EPI) { if (wr == 0) PG8_BAR; }
        if constexpr (!Epi::AFTER_DRAIN) { E(acc, cur, wr, wc, fr, fq); S.done(cur); }
        if (!has_next) break;
#pragma unroll
        for (int a = 0; a < 2; ++a)
#pragma unroll
            for (int b = 0; b < 2; ++b)
#pragma unroll
                for (int m = 0; m < 4; ++m)
#pragma unroll
                    for (int n = 0; n < 2; ++n) acc[a][b][m][n] = (f32x4){0.f, 0.f, 0.f, 0.f};
        cur = nxt; cA = nA; cB = nB; ++ui;
        if constexpr (ALIGN_EPI) { if (wr == 1) PG8_BAR; }
    }
    PG8_WAIT_V(0);
    if constexpr (!ALIGN_EPI) { if (wr == 0) PG8_BAR; }
    PG8_BAR;
    if constexpr (Epi::AFTER_DRAIN) { E.fused(acc, cur, wr, wc, fr, fq, lds, wid, lane); S.done(cur); }
#undef PG8_SA
#undef PG8_SB
#undef PG8_STAGE
#undef PG8_LDA
#undef PG8_LDB
#undef PG8_MMA
#undef PG8_WAIT_V
#undef PG8_WAIT_L
#undef PG8_BAR
#undef PG8_SCHED
}
}
#define GAS __attribute__((address_space(1)))
#define LAS __attribute__((address_space(3)))
typedef unsigned short bf16;
typedef unsigned v4u __attribute__((ext_vector_type(4)));
typedef float f32x4 __attribute__((ext_vector_type(4)));
typedef short bf16x8 __attribute__((ext_vector_type(8)));
typedef GAS unsigned gu32;
typedef GAS unsigned long long gu64;
#define RLX_AGENT __ATOMIC_RELAXED, __HIP_MEMORY_SCOPE_AGENT
#define LDS_WAIT() asm volatile("s_waitcnt lgkmcnt(0)" ::: "memory")
#define VM_WAIT() asm volatile("s_waitcnt vmcnt(0)" ::: "memory")
__device__ __forceinline__ unsigned long long rt() { return __builtin_amdgcn_s_memrealtime(); }
__device__ __forceinline__ unsigned f2bf(float f) { unsigned u = __builtin_bit_cast(unsigned, f); return (u + 0x7fffu + ((u >> 16) & 1u)) >> 16; }
__device__ __forceinline__ unsigned pk2(float lo, float hi) { return f2bf(lo) | (f2bf(hi) << 16); }

#define XB_TMO      128
#define XB_XCNT(j)  (256  + 64 * (j))
#define XB_XSUB(j)  (1280 + 64 * (j))
#define XB_XGEN(j)  (2304 + 64 * (j))
#define XB_TOP      3328
#define XB_TOPGEN   3392
#define XCD_BAR_WORDS 3456
#define XB_SPIN_CAP (1u << 18)

__device__ __forceinline__ unsigned xb_ld(unsigned* p)              { return __hip_atomic_load(p, __ATOMIC_RELAXED, __HIP_MEMORY_SCOPE_AGENT); }
__device__ __forceinline__ unsigned xb_add(unsigned* p, unsigned v) { return __hip_atomic_fetch_add(p, v, __ATOMIC_RELAXED, __HIP_MEMORY_SCOPE_AGENT); }
__device__ __forceinline__ unsigned xb_xcc_id() { return (unsigned)__builtin_amdgcn_s_getreg((3 << 11) | 20) & 0xFu; }
#define XB_SPIN(cond, bar) do { unsigned _sp = 0; while (cond) { __builtin_amdgcn_s_sleep(1); \
    if ((++_sp & 255u) == 0u) { if (xb_ld(&(bar)[XB_TMO])) break; if (_sp > XB_SPIN_CAP) { atomicAdd(&(bar)[XB_TMO], 1u); break; } } } } while (0)

struct XcdBarrier {
    unsigned* bar; unsigned x;
    volatile LAS unsigned* st;
};

__device__ __forceinline__ XcdBarrier xcd_barrier_post(unsigned* bar, volatile LAS unsigned* st) {
    XcdBarrier b; b.bar = bar; b.x = xb_xcc_id(); b.st = st;
    if (threadIdx.x == 0) (void)xb_add(&bar[XB_XCNT(b.x)], 1u);
    return b;
}
__device__ __forceinline__ void xcd_barrier_complete(unsigned* bar, unsigned x, unsigned& nloc, unsigned& nx) {
    const unsigned G = gridDim.x * gridDim.y * gridDim.z;
    unsigned sum, cnt, mine, sp = 0u;
    for (;;) {
        sum = 0u; cnt = 0u; mine = 0u;
#pragma unroll
        for (unsigned j = 0; j < 16; ++j) { const unsigned c = xb_ld(&bar[XB_XCNT(j)]); sum += c; cnt += (c > 0u) ? 1u : 0u; mine = (j == x) ? c : mine; }
        if (sum == G) break;
        __builtin_amdgcn_s_sleep(1);
        if ((++sp & 255u) == 0u) { if (xb_ld(&bar[XB_TMO])) break; if (sp > XB_SPIN_CAP) { atomicAdd(&bar[XB_TMO], 1u); break; } }
    }
    nloc = mine > 0u ? mine : 1u; nx = cnt > 0u ? cnt : 1u;
}

__device__ __forceinline__ void xcd_barrier(const XcdBarrier& b) {
    asm volatile("s_waitcnt vmcnt(0)" ::: "memory");
    __syncthreads();
    if (threadIdx.x == 0) {
        unsigned* bar = b.bar;
        __builtin_amdgcn_s_waitcnt(0);
        unsigned nloc = b.st[0], nx = b.st[1];
        if (nloc == 0u) { xcd_barrier_complete(bar, b.x, nloc, nx); b.st[0] = nloc; b.st[1] = nx; }
        const unsigned old = xb_add(&bar[XB_XSUB(b.x)], 1u);
        const unsigned gen = old / nloc;
        if (old + 1u == (gen + 1u) * nloc) {
            __builtin_amdgcn_fence(__ATOMIC_RELEASE, "agent");
            asm volatile("s_waitcnt vmcnt(0)" ::: "memory");
            const unsigned og = xb_add(&bar[XB_TOP], 1u);
            const unsigned tg = og / nx;
            if (og + 1u == (tg + 1u) * nx) xb_add(&bar[XB_TOPGEN], 1u);
            else XB_SPIN(xb_ld(&bar[XB_TOPGEN]) == tg, bar);
            __builtin_amdgcn_fence(__ATOMIC_ACQUIRE, "agent");
            xb_add(&bar[XB_XGEN(b.x)], 1u);
            asm volatile("s_waitcnt vmcnt(0)" ::: "memory");
        } else {
            XB_SPIN(xb_ld(&bar[XB_XGEN(b.x)]) == gen, bar);
            __builtin_amdgcn_fence(__ATOMIC_ACQUIRE, "agent");
            asm volatile("s_waitcnt vmcnt(0)" ::: "memory");
        }
    }
    __syncthreads();
}

constexpr int NWAVES = 8;
constexpr int BATCH = 4, SEQ = 2048, DM = 2048, DFF = 5632, DEPTH = 4, DS5 = 1024, DCONV = 1024, DIN = 4096, S5G = 64, S5P = 16, S5N = 64;
constexpr int M = BATCH * SEQ;
constexpr float LN_EPS = 1e-5f, RMS_EPS = 1e-6f, DN_ALPHA = 1.6817928305074292f;
#ifndef MK_PER_PHASE
#define MK_PER_PHASE 0
#endif
#ifndef S5_NAIVE
#define S5_NAIVE 1
#endif
constexpr int NPHASE = 1 + 8 * 3 + 4 * 6;

constexpr size_t MiB = 1u << 20;
constexpr size_t WS_CTL = 0, CTL_ZERO_BYTES = 1 * MiB;
constexpr size_t WS_W = 1 * MiB;
constexpr size_t SZ_WGU = (size_t)2 * DFF * DM * 2, SZ_WD = (size_t)DM * DFF * 2, SZ_WIN = (size_t)DIN * DM * 2, SZ_WGLU = (size_t)DS5 * DS5 * 2, SZ_WOUT = (size_t)DM * DM * 2;
constexpr size_t OFF_WGU1 = 0, OFF_WD1 = OFF_WGU1 + SZ_WGU, OFF_WGU2 = OFF_WD1 + SZ_WD, OFF_WD2 = OFF_WGU2 + SZ_WGU, OFF_WIN = OFF_WD2 + SZ_WD, OFF_WGLU = OFF_WIN + SZ_WIN, OFF_WOUT = OFF_WGLU + SZ_WGLU;
constexpr size_t SZ_LAYER = OFF_WOUT + SZ_WOUT;
constexpr size_t WS_XF = WS_W + DEPTH * SZ_LAYER;
constexpr size_t WS_V = WS_XF + (size_t)M * DM * 4;
constexpr size_t WS_XB = WS_V + (size_t)M * DM * 4;
constexpr size_t WS_H = WS_XB + (size_t)M * DM * 2;
constexpr size_t WS_U = WS_H + (size_t)M * DFF * 2;
constexpr size_t WS_GB = WS_U + (size_t)M * DS5 * 2;
constexpr size_t WS_Y = WS_GB + (size_t)M * 3072 * 2;
constexpr size_t WS_YG = WS_Y + (size_t)M * DS5 * 2;
constexpr size_t WS_YZ = WS_YG + (size_t)M * DS5 * 2;
constexpr size_t WS_END = WS_YZ + (size_t)M * DM * 2;
constexpr int CW_TMO = 0, CW_CODE = 1, CW_BAR = 4096;

constexpr int RING_OFF = 0, RING_BYTES = 131072;
constexpr int LDS_BYTES = 147456;
constexpr int MISC_OFF = LDS_BYTES - 512;

__device__ __forceinline__ float bflo(unsigned w) { return __uint_as_float(w << 16); }
__device__ __forceinline__ float bfhi(unsigned w) { return __uint_as_float(w & 0xffff0000u); }

struct Frame {
    LAS unsigned char* lds;
    volatile LAS unsigned* MISC;
    gu32* ctl;
    int tid, lane, wave, vcu, G;
    const float* const* in;
};
struct Args { const float* in[28]; float* out; unsigned char* ws; int ph_lo, ph_hi, use_bar, pad; };
__device__ __forceinline__ int opq(int i) { asm volatile("" : "+s"(i)); return i; }

__device__ __forceinline__ float wave_sum(float v, int lane) {
#pragma unroll
    for (int o = 1; o < 64; o <<= 1) v += __int_as_float(__builtin_amdgcn_ds_bpermute((lane ^ o) << 2, __float_as_int(v)));
    return v;
}
__device__ __forceinline__ void transpose_item(const float* W, int K, int N, bf16* WT, int k0, int n0, int drow, LAS float* scr, int lane) {
#pragma unroll 8
    for (int i = 0; i < 32; ++i) { const int kk = 2 * i + (lane >> 5); scr[kk * 33 + (lane & 31)] = W[(size_t)(k0 + kk) * N + n0 + (lane & 31)]; }
    LDS_WAIT(); asm volatile("" ::: "memory");
    const int c = lane & 7;
#pragma unroll
    for (int j = 0; j < 4; ++j) { const int n = (lane >> 3) + 8 * j; const LAS float* s = scr + (8 * c) * 33 + n;
        v4u o; o.x = pk2(s[0 * 33], s[1 * 33]); o.y = pk2(s[2 * 33], s[3 * 33]); o.z = pk2(s[4 * 33], s[5 * 33]); o.w = pk2(s[6 * 33], s[7 * 33]);
        *(GAS v4u*)(WT + (size_t)(drow + n) * K + k0 + 8 * c) = o; }
    LDS_WAIT(); asm volatile("" ::: "memory");
}
__device__ __forceinline__ void transpose_matrix(const float* W, int K, int N, bf16* WT, int mode, LAS float* scr, int gw, int NGW, int lane) {
    const int nblk = N / 32, nitems = (K / 64) * nblk;
    for (int it = gw; it < nitems; it += NGW) {
        const int kb = it / nblk, nb = it % nblk, n0 = 32 * nb;
        const int drow = (mode == 0) ? n0 : ((n0 >> 7) * 256 + (n0 & 127) + (mode == 2 ? 128 : 0));
        transpose_item(W, K, N, WT, 64 * kb, n0, drow, scr, lane);
    }
}

__device__ __forceinline__ void ln_row(const float* vrow, const float* g, const float* b, float* xf, bf16* xb, int lane) {
    const GAS f32x4* xr = (const GAS f32x4*)vrow + lane;
    f32x4 v[8]; float s = 0.f;
#pragma unroll
    for (int j = 0; j < 8; ++j) { v[j] = xr[64 * j]; s += (v[j].x + v[j].y) + (v[j].z + v[j].w); }
    const float mean = wave_sum(s, lane) * (1.f / DM); float s2 = 0.f;
#pragma unroll
    for (int j = 0; j < 8; ++j) { v[j] = v[j] - mean; s2 += (v[j].x * v[j].x + v[j].y * v[j].y) + (v[j].z * v[j].z + v[j].w * v[j].w); }
    const float rstd = 1.f / sqrtf(wave_sum(s2, lane) * (1.f / DM) + LN_EPS);
    GAS f32x4* of = (GAS f32x4*)xf + lane; GAS unsigned long long* ob = (GAS unsigned long long*)xb + lane;
    const GAS f32x4* gr = (const GAS f32x4*)g + lane; const GAS f32x4* br = (const GAS f32x4*)b + lane;
#pragma unroll
    for (int j = 0; j < 8; ++j) { const f32x4 o = v[j] * rstd * gr[64 * j] + br[64 * j]; of[64 * j] = o;
        ob[64 * j] = (unsigned long long)pk2(o.x, o.y) | ((unsigned long long)pk2(o.z, o.w) << 32); }
}

__device__ __forceinline__ float gelu_tanh(float x) {
    const float z2 = 1.5957691216057308f * (x + 0.044715f * x * x * x);
    return x * __builtin_amdgcn_rcpf(1.0f + __builtin_amdgcn_exp2f(z2 * -1.4426950408889634f));
}

__device__ __forceinline__ void sincos_f(float x, float& s, float& c) {
    const float k = rintf(x * 0.63661977236758134f);
    float r = fmaf(-k, 1.5707962513e+00f, x); r = fmaf(-k, 7.5497894159e-08f, r); r = fmaf(-k, 5.3903029534e-15f, r);
    const float r2 = r * r;
    float sp = fmaf(r2, 2.7557314297e-06f, -1.9841270114e-04f); sp = fmaf(sp, r2, 8.3333337680e-03f); sp = fmaf(sp, r2, -1.6666667163e-01f); sp = fmaf(sp * r2, r, r);
    float cp = fmaf(r2, 2.4433157118e-05f, -1.3887316255e-03f); cp = fmaf(cp, r2, 4.1666645683e-02f); cp = fmaf(cp, r2, -0.5f); cp = fmaf(cp, r2, 1.0f);
    const int q = (int)k & 3;
    const float ss = (q & 1) ? cp : sp, cc = (q & 1) ? sp : cp;
    s = (q & 2) ? -ss : ss; c = ((q + 1) & 2) ? -cc : cc;
}

#if S5_NAIVE
__device__ __forceinline__ void s5_naive_unit(Frame& F, const Args& A, int layer, int b, int g, const bf16* U, bf16* Y, const int tid) {
    const int lane = tid & 63;
    typedef float f32x2v __attribute__((ext_vector_type(2)));
    LAS f32x2v* Cs = (LAS f32x2v*)(F.lds + RING_OFF);
    LAS f32x2v* Ss = (LAS f32x2v*)(F.lds + RING_OFF + 8192);
    LAS float* Us = (LAS float*)(F.lds + RING_OFF + 8192 + 32768);
    LAS float* Dd = (LAS float*)(F.lds + RING_OFF + 8192 + 32768 + 4096);
    const int lg = layer * S5G + g;
    const float* c_re = A.in[opq(12)] + (size_t)lg * S5P * S5N; const float* c_im = A.in[opq(13)] + (size_t)lg * S5P * S5N;
    for (int i = tid; i < S5P * S5N; i += NWAVES * 64) Cs[i] = (f32x2v){c_re[i], c_im[i]};
    if (tid < 16) Dd[tid] = A.in[opq(14)][lg * S5P + tid];
    float are = 0.f, aim = 0.f, bbr[16], bbi[16], sre = 0.f, sim = 0.f;
#pragma unroll
    for (int p = 0; p < 16; ++p) { bbr[p] = 0.f; bbi[p] = 0.f; }
    if (F.wave == 0) {
        const int n = lane; const float lre = A.in[opq(7)][lg * S5N + n], lim = A.in[opq(8)][lg * S5N + n], dt = expf(A.in[opq(9)][lg]);
        const float mag = expf(lre * dt); float sn, cs; sincos_f(lim * dt, sn, cs);
        are = mag * cs; aim = mag * sn;
        const float den = lre * lre + lim * lim, nr = are - 1.0f, ni = aim, qre = (nr * lre + ni * lim) / den, qim = (ni * lre - nr * lim) / den;
        const float* bre = A.in[opq(10)] + ((size_t)lg * S5N + n) * S5P; const float* bim = A.in[opq(11)] + ((size_t)lg * S5N + n) * S5P;
#pragma unroll
        for (int p = 0; p < 16; ++p) { const float br = bre[p], bi = bim[p]; bbr[p] = qre * br - qim * bi; bbi[p] = qre * bi + qim * br; }
    }
    const bf16* Ub = U + ((size_t)(b * S5G + g) * SEQ) * S5P;
    for (int blk = 0; blk < SEQ / 64; ++blk) {
        __syncthreads();
        for (int i = tid; i < 64 * 16; i += NWAVES * 64) Us[i] = __uint_as_float(((unsigned)Ub[(size_t)blk * 1024 + i]) << 16);
        __syncthreads();
        if (F.wave == 0) {
            for (int t = 0; t < 64; ++t) {
                float bur = 0.f, bui = 0.f;
#pragma unroll
                for (int p = 0; p < 16; ++p) { const float uv = Us[t * 16 + p]; bur = fmaf(bbr[p], uv, bur); bui = fmaf(bbi[p], uv, bui); }
                const float nre = are * sre - aim * sim + bur, nim = are * sim + aim * sre + bui;
                sre = nre; sim = nim;
                Ss[t * 64 + lane] = (f32x2v){sre, sim};
            }
        }
        __syncthreads();
#pragma unroll
        for (int r = 0; r < 2; ++r) {
            const int o = tid + r * 512, t = o >> 4, p = o & 15;
            float acc = Dd[p] * Us[t * 16 + p];
#pragma unroll 4
            for (int n = 0; n < 64; ++n) { const f32x2v c = Cs[p * 64 + n], s = Ss[t * 64 + n]; acc = fmaf(c.x, s.x, acc); acc = fmaf(-c.y, s.y, acc); }
            Y[(size_t)(b * SEQ + blk * 64 + t) * DS5 + g * S5P + p] = (bf16)f2bf(gelu_tanh(acc));
        }
    }
    __syncthreads();
}
#endif

__device__ __forceinline__ void unpack8(const v4u w, float (&o)[8]) {
    o[0] = bflo(w.x); o[1] = bfhi(w.x); o[2] = bflo(w.y); o[3] = bfhi(w.y); o[4] = bflo(w.z); o[5] = bfhi(w.z); o[6] = bflo(w.w); o[7] = bfhi(w.w);
}
__device__ __forceinline__ v4u pack8(const float (&o)[8]) { v4u w; w.x = pk2(o[0], o[1]); w.y = pk2(o[2], o[3]); w.z = pk2(o[4], o[5]); w.w = pk2(o[6], o[7]); return w; }
__device__ __forceinline__ void conv_rows(const Args& A, int layer, const bf16* GB, bf16* YZ, int gw, int NGW, int lane) {
    const float* cw = A.in[opq(16)] + (size_t)layer * 3 * DCONV; const float* cb = A.in[opq(17)] + (size_t)layer * DCONV; const float* gc = A.in[opq(19)] + (size_t)layer * DCONV;
    for (int grp = gw; grp < M / 4; grp += NGW) {
        const int row0 = grp * 4, l0 = row0 & (SEQ - 1);
        float vm2[2][8], vm1[2][8];
#pragma unroll
        for (int j = 0; j < 2; ++j) { const int c0 = (64 * j + lane) * 8;
#pragma unroll
            for (int e = 0; e < 8; ++e) { vm2[j][e] = 0.f; vm1[j][e] = 0.f; }
            if (l0 >= 2) {
                float a[8], h[8];
                unpack8(*(const GAS v4u*)(GB + (size_t)(row0 - 2) * 3072 + 1024 + c0), a); unpack8(*(const GAS v4u*)(GB + (size_t)(row0 - 2) * 3072 + 2048 + c0), h);
#pragma unroll
                for (int e = 0; e < 8; ++e) vm2[j][e] = a[e] * h[e];
                unpack8(*(const GAS v4u*)(GB + (size_t)(row0 - 1) * 3072 + 1024 + c0), a); unpack8(*(const GAS v4u*)(GB + (size_t)(row0 - 1) * 3072 + 2048 + c0), h);
#pragma unroll
                for (int e = 0; e < 8; ++e) vm1[j][e] = a[e] * h[e];
            } }
#pragma unroll 1
        for (int r = 0; r < 4; ++r) {
            const size_t ro = (size_t)(row0 + r) * 3072;
            float z[2][8]; float ss = 0.f;
#pragma unroll
            for (int j = 0; j < 2; ++j) { const int c0 = (64 * j + lane) * 8;
                float gb[8], a[8], h[8];
                unpack8(*(const GAS v4u*)(GB + ro + c0), gb); unpack8(*(const GAS v4u*)(GB + ro + 1024 + c0), a); unpack8(*(const GAS v4u*)(GB + ro + 2048 + c0), h);
                const f32x4 w0a = *(const GAS f32x4*)(cw + c0), w0b = *(const GAS f32x4*)(cw + c0 + 4), w1a = *(const GAS f32x4*)(cw + DCONV + c0), w1b = *(const GAS f32x4*)(cw + DCONV + c0 + 4);
                const f32x4 w2a = *(const GAS f32x4*)(cw + 2 * DCONV + c0), w2b = *(const GAS f32x4*)(cw + 2 * DCONV + c0 + 4), bba = *(const GAS f32x4*)(cb + c0), bbb = *(const GAS f32x4*)(cb + c0 + 4);
#pragma unroll
                for (int e = 0; e < 8; ++e) { const float v0 = a[e] * h[e]; const float w0 = e < 4 ? w0a[e & 3] : w0b[e & 3], w1 = e < 4 ? w1a[e & 3] : w1b[e & 3], w2 = e < 4 ? w2a[e & 3] : w2b[e & 3], bb = e < 4 ? bba[e & 3] : bbb[e & 3];
                    z[j][e] = gb[e] * (bb + w0 * vm2[j][e] + w1 * vm1[j][e] + w2 * v0); ss += z[j][e] * z[j][e]; vm2[j][e] = vm1[j][e]; vm1[j][e] = v0; } }
            const float rs = 1.f / sqrtf(wave_sum(ss, lane) * (1.f / DCONV) + RMS_EPS);
#pragma unroll
            for (int j = 0; j < 2; ++j) { const int c0 = (64 * j + lane) * 8; float o[8];
                const f32x4 ga = *(const GAS f32x4*)(gc + c0), gb4 = *(const GAS f32x4*)(gc + c0 + 4);
#pragma unroll
                for (int e = 0; e < 8; ++e) o[e] = z[j][e] * rs * (e < 4 ? ga[e & 3] : gb4[e & 3]);
                *(GAS v4u*)(YZ + (size_t)(row0 + r) * DM + DS5 + c0) = pack8(o); }
        }
    }
}
__device__ __forceinline__ void ynorm_rows(const Args& A, int layer, const bf16* YG, bf16* YZ, int gw, int NGW, int lane) {
    const float* gs = A.in[opq(18)] + (size_t)layer * DS5;
    float gg[2][8];
#pragma unroll
    for (int j = 0; j < 2; ++j) { const int c0 = (64 * j + lane) * 8;
#pragma unroll
        for (int e = 0; e < 8; ++e) gg[j][e] = gs[c0 + e]; }
    for (int row = gw; row < M; row += NGW) {
        float y[2][8]; float ss = 0.f;
#pragma unroll
        for (int j = 0; j < 2; ++j) { unpack8(*(const GAS v4u*)(YG + (size_t)row * DS5 + (64 * j + lane) * 8), y[j]);
#pragma unroll
            for (int e = 0; e < 8; ++e) ss += y[j][e] * y[j][e]; }
        const float rs = 1.f / sqrtf(wave_sum(ss, lane) * (1.f / DS5) + RMS_EPS);
#pragma unroll
        for (int j = 0; j < 2; ++j) { float o[8];
#pragma unroll
            for (int e = 0; e < 8; ++e) o[e] = y[j][e] * rs * gg[j][e];
            *(GAS v4u*)(YZ + (size_t)row * DM + (64 * j + lane) * 8) = pack8(o); }
    }
}

#ifndef P_PRO
#define P_PRO 1
#endif
#ifndef P_G1
#define P_G1 1
#endif
#ifndef P_G2
#define P_G2 1
#endif
#ifndef P_LN
#define P_LN 1
#endif
#ifndef P_G3
#define P_G3 1
#endif
#ifndef P_S5
#define P_S5 1
#endif
#ifndef P_G4
#define P_G4 1
#endif
#ifndef P_YN
#define P_YN 1
#endif
#ifndef P_G5
#define P_G5 1
#endif
#ifndef P_LN2
#define P_LN2 1
#endif
__global__ void __launch_bounds__(NWAVES * 64, 2) fwd(Args args) {
    extern __shared__ __attribute__((aligned(16))) unsigned char lds[];
    Frame F;
    F.lds = (LAS unsigned char*)lds;
    F.MISC = (volatile LAS unsigned*)(F.lds + MISC_OFF);
    F.tid = threadIdx.x; F.lane = F.tid & 63; F.wave = __builtin_amdgcn_readfirstlane(F.tid >> 6);
    F.G = gridDim.x; { const int bx = blockIdx.x; F.vcu = (F.G % 8 == 0) ? (bx % 8) * (F.G / 8) + bx / 8 : bx; }
    unsigned char* ws = args.ws;
    F.ctl = (gu32*)(ws + WS_CTL);
    for (int u = F.tid; u < (LDS_BYTES - MISC_OFF) / 4; u += NWAVES * 64) ((LAS unsigned*)(F.lds + MISC_OFF))[u] = 0u;
    __syncthreads();
    XcdBarrier bar; bar.bar = (unsigned*)(F.ctl + CW_BAR); bar.x = 0; bar.st = nullptr;
    if (args.use_bar) bar = xcd_barrier_post((unsigned*)(F.ctl + CW_BAR), F.MISC + 8);
    const int lo = args.ph_lo, hi = args.ph_hi;
    int ph = 0;
#define IN(k) (lo <= (k) && (k) < hi)
#define PHASE_LANE() int pm1 = -1; asm volatile("" : "+s"(pm1)); int ptid = F.wave * 64 + (int)__builtin_amdgcn_mbcnt_hi((unsigned)pm1, __builtin_amdgcn_mbcnt_lo((unsigned)pm1, 0u)); asm volatile("" : "+v"(ptid)); const int plane = ptid & 63; (void)plane
#define SEAM(k) do { if (IN(k) && IN((k) + 1)) xcd_barrier(bar); } while (0)
    const int gw = F.vcu * NWAVES + F.wave, NGW = F.G * NWAVES;
    bf16* XB = (bf16*)(ws + WS_XB); float* XF = (float*)(ws + WS_XF); float* V = (float*)(ws + WS_V); bf16* H = (bf16*)(ws + WS_H);
    bf16* U = (bf16*)(ws + WS_U); bf16* GB = (bf16*)(ws + WS_GB); bf16* Y = (bf16*)(ws + WS_Y); bf16* YG = (bf16*)(ws + WS_YG); bf16* YZ = (bf16*)(ws + WS_YZ);

    if (P_PRO && IN(ph)) {
        PHASE_LANE();
        LAS float* scr = (LAS float*)(F.lds + RING_OFF + F.wave * 16384);
        for (int l = 0; l < DEPTH; ++l) {
            unsigned char* wl = ws + WS_W + (size_t)l * SZ_LAYER;
            transpose_matrix(args.in[opq(1)] + (size_t)l * DM * DFF, DM, DFF, (bf16*)(wl + OFF_WGU1), 1, scr, gw, NGW, plane);
            transpose_matrix(args.in[opq(2)] + (size_t)l * DM * DFF, DM, DFF, (bf16*)(wl + OFF_WGU1), 2, scr, gw, NGW, plane);
            transpose_matrix(args.in[opq(3)] + (size_t)l * DFF * DM, DFF, DM, (bf16*)(wl + OFF_WD1), 0, scr, gw, NGW, plane);
            transpose_matrix(args.in[opq(23)] + (size_t)l * DM * DFF, DM, DFF, (bf16*)(wl + OFF_WGU2), 1, scr, gw, NGW, plane);
            transpose_matrix(args.in[opq(24)] + (size_t)l * DM * DFF, DM, DFF, (bf16*)(wl + OFF_WGU2), 2, scr, gw, NGW, plane);
            transpose_matrix(args.in[opq(25)] + (size_t)l * DFF * DM, DFF, DM, (bf16*)(wl + OFF_WD2), 0, scr, gw, NGW, plane);
            transpose_matrix(args.in[opq(6)] + (size_t)l * DM * DIN, DM, DIN, (bf16*)(wl + OFF_WIN), 0, scr, gw, NGW, plane);
            transpose_matrix(args.in[opq(15)] + (size_t)l * DS5 * DS5, DS5, DS5, (bf16*)(wl + OFF_WGLU), 0, scr, gw, NGW, plane);
            transpose_matrix(args.in[opq(20)] + (size_t)l * DM * DM, DM, DM, (bf16*)(wl + OFF_WOUT), 0, scr, gw, NGW, plane);
        }
        const size_t n8 = (size_t)M * DM / 8;
        for (size_t i = (size_t)blockIdx.x * (NWAVES * 64) + ptid; i < n8; i += (size_t)F.G * NWAVES * 64) {
            const f32x4 a = ((const GAS f32x4*)args.in[opq(0)])[2 * i], b = ((const GAS f32x4*)args.in[opq(0)])[2 * i + 1];
            v4u o; o.x = pk2(a.x, a.y); o.y = pk2(a.z, a.w); o.z = pk2(b.x, b.y); o.w = pk2(b.z, b.w);
            ((GAS v4u*)XB)[i] = o;
        }
    }
    SEAM(ph); ++ph;

    for (int fi = 0; fi < 2 * DEPTH; ++fi) {
        const int layer = fi >> 1, second = fi & 1;
        unsigned char* wl = ws + WS_W + (size_t)layer * SZ_LAYER;
        if (P_G1 && IN(ph)) {
            pg8::Gemm g{XB, (const bf16*)(wl + (second ? OFF_WGU2 : OFF_WGU1)), M, 2 * DFF, DM}; pg8::StaticOrder S; S.init(M, 2 * DFF, F.G, (int)blockIdx.x);
            pg8::EpiSwiglu E{H, DFF};
            pg8::gemm_phase<pg8::EpiSwiglu, pg8::StaticOrder, true, true>(F.lds + RING_OFF, g, S, E, F.wave);
        }
        SEAM(ph); ++ph;
        if (P_G2 && IN(ph)) {
            const float* R = (fi == 0) ? args.in[opq(0)] : XF;
            pg8::Gemm g{H, (const bf16*)(wl + (second ? OFF_WD2 : OFF_WD1)), M, DM, DFF}; pg8::StaticOrder S; S.init(M, DM, F.G, (int)blockIdx.x);
            pg8::EpiResF32 E{R, V, DM, DN_ALPHA, 0.5f};
            pg8::gemm_phase<pg8::EpiResF32, pg8::StaticOrder, true, true>(F.lds + RING_OFF, g, S, E, F.wave);
        }
        SEAM(ph); ++ph;
        if (P_LN && IN(ph)) {
            PHASE_LANE();
            const float* g = args.in[opq(second ? 26 : 4)] + (size_t)layer * DM; const float* b = args.in[opq(second ? 27 : 5)] + (size_t)layer * DM;
            float* xo = (fi == 2 * DEPTH - 1) ? args.out : XF;
            for (int m = gw; m < M; m += NGW) ln_row(V + (size_t)m * DM, g, b, xo + (size_t)m * DM, XB + (size_t)m * DM, plane);
        }
        SEAM(ph); ++ph;
        if (second) continue;
        if (P_G3 && IN(ph)) {
            pg8::Gemm g{XB, (const bf16*)(wl + OFF_WIN), M, DIN, DM}; pg8::StaticOrder S; S.init(M, DIN, F.G, (int)blockIdx.x);
            pg8::EpiProj E{U, GB};
            pg8::gemm_phase<pg8::EpiProj, pg8::StaticOrder, true, true>(F.lds + RING_OFF, g, S, E, F.wave);
        }
        SEAM(ph); ++ph;
        if (P_S5 && IN(ph)) {
            PHASE_LANE();
            for (int unit = F.vcu; unit < BATCH * S5G; unit += F.G) s5_naive_unit(F, args, layer, unit / S5G, unit % S5G, U, Y, ptid);
            conv_rows(args, layer, GB, YZ, gw, NGW, plane);
        }
        SEAM(ph); ++ph;
        if (P_G4 && IN(ph)) {
            pg8::Gemm g{Y, (const bf16*)(wl + OFF_WGLU), M, DS5, DS5}; pg8::StaticOrder S; S.init(M, DS5, F.G, (int)blockIdx.x);
            pg8::EpiGlu E{Y, YG, DS5};
            pg8::gemm_phase<pg8::EpiGlu, pg8::StaticOrder, true, true>(F.lds + RING_OFF, g, S, E, F.wave);
        }
        SEAM(ph); ++ph;
        if (P_YN && IN(ph)) { PHASE_LANE(); ynorm_rows(args, layer, YG, YZ, gw, NGW, plane); }
        SEAM(ph); ++ph;
        if (P_G5 && IN(ph)) {
            pg8::Gemm g{YZ, (const bf16*)(wl + OFF_WOUT), M, DM, DM}; pg8::StaticOrder S; S.init(M, DM, F.G, (int)blockIdx.x);
            pg8::EpiResF32 E{XF, V, DM, DN_ALPHA, 1.0f};
            pg8::gemm_phase<pg8::EpiResF32, pg8::StaticOrder, true, true>(F.lds + RING_OFF, g, S, E, F.wave);
        }
        SEAM(ph); ++ph;
        if (P_LN2 && IN(ph)) {
            PHASE_LANE();
            const float* g = args.in[opq(21)] + (size_t)layer * DM; const float* b = args.in[opq(22)] + (size_t)layer * DM;
            for (int m = gw; m < M; m += NGW) ln_row(V + (size_t)m * DM, g, b, XF + (size_t)m * DM, XB + (size_t)m * DM, plane);
        }
        SEAM(ph); ++ph;
    }
#undef IN
#undef SEAM
}

extern "C" void kernel_launch(void* const* d_in, const int* in_sizes, int n_in, void* d_out, int out_size, void* d_ws, size_t ws_size, hipStream_t stream) {
    static int grid = 0;
    if (grid == 0) {
        if (n_in != 28 || in_sizes[0] != M * DM || out_size != M * DM || ws_size < WS_END) { fprintf(stderr, "kernel_launch: unexpected shapes (n_in %d, in0 %d, out %d, ws %zu < %zu); nothing launched\n", n_in, n_in > 0 ? in_sizes[0] : -1, out_size, ws_size, (size_t)WS_END); grid = -1; return; }
        int dev = 0, cus = 0, per_cu = 0;
        if (hipGetDevice(&dev) != hipSuccess || hipDeviceGetAttribute(&cus, hipDeviceAttributeMultiprocessorCount, dev) != hipSuccess) { grid = -1; return; }
        if (hipFuncSetAttribute((const void*)fwd, hipFuncAttributeMaxDynamicSharedMemorySize, LDS_BYTES) != hipSuccess) { fprintf(stderr, "kernel_launch: hipFuncSetAttribute failed\n"); grid = -1; return; }
        if (hipOccupancyMaxActiveBlocksPerMultiprocessor(&per_cu, (const void*)fwd, NWAVES * 64, LDS_BYTES) != hipSuccess || per_cu < 1) fprintf(stderr, "kernel_launch: occupancy query reports %d\n", per_cu);
        (void)hipGetLastError();
        grid = cus;
    }
    if (grid < 0) return;
    if (hipMemsetAsync((char*)d_ws + WS_CTL, 0, CTL_ZERO_BYTES, stream) != hipSuccess) return;
    Args a{};
    for (int i = 0; i < 28; ++i) a.in[i] = (const float*)d_in[i];
    a.out = (float*)d_out; a.ws = (unsigned char*)d_ws; a.pad = 0;
#if MK_PER_PHASE
    for (int k = 0; k < NPHASE; ++k) { a.ph_lo = k; a.ph_hi = k + 1; a.use_bar = 0; hipLaunchKernelGGL(fwd, dim3(grid), dim3(NWAVES * 64), LDS_BYTES, stream, a); }
#else
    a.ph_lo = 0; a.ph_hi = NPHASE; a.use_bar = 1;
    hipLaunchKernelGGL(fwd, dim3(grid), dim3(NWAVES * 64), LDS_BYTES, stream, a);
#endif
    const hipError_t le = hipPeekAtLastError();
    if (le != hipSuccess) fprintf(stderr, "kernel_launch: launch failed: %s\n", hipGetErrorName(le));
}
```

```cpp
#include <hip/hip_runtime.h>
#include <cstdio>
#include <cstdint>
namespace pg8 {
#define PG8_LAS __attribute__((address_space(3)))
typedef unsigned short bf16_t;
typedef short bf16x8 __attribute__((ext_vector_type(8)));
typedef float f32x4 __attribute__((ext_vector_type(4)));
typedef unsigned u32x4 __attribute__((ext_vector_type(4)));
constexpr int BM = 256, BK = 64, HALF = 128, HTB = HALF * BK * 2  , STAGE_BYTES = 8 * HTB, NXCD = 8, WGM = 8;

__host__ __device__ __forceinline__ int lds_byte(int r, int c) { const int st = (r >> 4) * 2 + (c >> 5), rr = r & 15, cc = c & 31, ob = rr * 64 + cc * 2; return st * 1024 + (ob ^ (((ob >> 9) & 1) << 5)); }
__host__ __device__ __forceinline__ void stage_rc(int b, int& R, int& C) { const int st = b / 1024, sb = b % 1024, swz = sb ^ (((sb >> 9) & 1) << 5); R = (st >> 1) * 16 + swz / 64; C = (st & 1) * 32 + (swz % 64) / 2; }
__host__ __device__ __forceinline__ int perm32(int rho) { const int n = rho >> 4, i = rho & 15; return 8 * (i >> 2) + 4 * n + (i & 3); }

struct Unit { int pm, pn; };
struct Gemm { const bf16_t* A; const bf16_t* Bt; int M, N, K; };

struct StaticOrder {
    int nM, nN, nwg, G, c;
    __host__ __device__ void init(int M, int N, int G_, int c_) { nM = M / BM; nN = N / BM; nwg = nM * nN; G = G_; c = c_; }
    __host__ __device__ bool next(int i, Unit& u) const {
        const long L = (long)i * G + c; if (L >= nwg) return false;
        int wgid = (int)L; { const int q = nwg / NXCD, r = nwg % NXCD, xcd = wgid % NXCD, off = wgid / NXCD; wgid = (xcd < r ? xcd * (q + 1) : r * (q + 1) + (xcd - r) * q) + off; }
        const int nig = WGM * nN, gid = wgid / nig, fm = gid * WGM, gsz = (nM - fm) < WGM ? (nM - fm) : WGM;
        u.pm = fm + ((wgid % nig) % gsz); u.pn = (wgid % nig) / gsz; return true;
    }
    __device__ __forceinline__ void a_ready(const Unit&) const {}
    __device__ __forceinline__ void done(const Unit&) const {}
};

__device__ __forceinline__ unsigned cvt_pk_bf16(float lo, float hi) { unsigned r; asm volatile("v_cvt_pk_bf16_f32 %0, %1, %2" : "=v"(r) : "v"(lo), "v"(hi)); return r; }
typedef float f32x2 __attribute__((ext_vector_type(2)));
__device__ __forceinline__ float sigmoid_f(float x) { return __builtin_amdgcn_rcpf(1.0f + __builtin_amdgcn_exp2f(x * -1.4426950408889634f)); }
__device__ __forceinline__ float bf2f(unsigned short h) { return __uint_as_float(((unsigned)h) << 16); }
struct EpiSwiglu {
    static constexpr bool PERM = true, AFTER_DRAIN = false;
    bf16_t* H; int ldh;
    __device__ __forceinline__ void operator()(const f32x4 (&acc)[2][2][4][2], const Unit& u, int wr, int wc, int fr, int fq) const {
        const int row0 = u.pm * BM + wr * 64 + fr, col0 = u.pn * HALF + wc * 32 + 8 * fq;
#pragma unroll
        for (int ai = 0; ai < 2; ++ai)
#pragma unroll
            for (int m = 0; m < 4; ++m) { bf16_t* p = H + (size_t)(row0 + ai * HALF + m * 16) * ldh + col0;
                float o[8];
#pragma unroll
                for (int n = 0; n < 2; ++n)
#pragma unroll
                    for (int e = 0; e < 4; ++e) { const float g = acc[ai][0][m][n][e], up = acc[ai][1][m][n][e]; o[n * 4 + e] = g * sigmoid_f(g) * up; }
                u32x4 w; w.x = cvt_pk_bf16(o[0], o[1]); w.y = cvt_pk_bf16(o[2], o[3]); w.z = cvt_pk_bf16(o[4], o[5]); w.w = cvt_pk_bf16(o[6], o[7]);
                *(u32x4*)p = w; }
    }
};
struct EpiResF32 {
    static constexpr bool PERM = false, AFTER_DRAIN = false;
    const float* R; float* V; int ldc; float alpha, scale;
    __device__ __forceinline__ void operator()(const f32x4 (&acc)[2][2][4][2], const Unit& u, int wr, int wc, int fr, int fq) const {
        const int row0 = u.pm * BM + wr * 64 + fr, col0 = u.pn * BM + wc * 32 + 4 * fq;
#pragma unroll
        for (int ai = 0; ai < 2; ++ai)
#pragma unroll
            for (int m = 0; m < 4; ++m) { const size_t off = (size_t)(row0 + ai * HALF + m * 16) * ldc + col0;
#pragma unroll
                for (int bj = 0; bj < 2; ++bj)
#pragma unroll
                    for (int n = 0; n < 2; ++n) { const f32x4 r = *(const f32x4*)(R + off + bj * HALF + n * 16);
                        *(f32x4*)(V + off + bj * HALF + n * 16) = r * alpha + acc[ai][bj][m][n] * scale; } }
    }
};
struct EpiProj {
    static constexpr bool PERM = true, AFTER_DRAIN = false;
    bf16_t* U; bf16_t* GB;
    __device__ __forceinline__ void operator()(const f32x4 (&acc)[2][2][4][2], const Unit& u, int wr, int wc, int fr, int fq) const {
        const int row0 = u.pm * BM + wr * 64 + fr;
#pragma unroll
        for (int ai = 0; ai < 2; ++ai)
#pragma unroll
            for (int m = 0; m < 4; ++m) { const int row = row0 + ai * HALF + m * 16;
#pragma unroll
                for (int bj = 0; bj < 2; ++bj) { const int col = u.pn * BM + bj * HALF + wc * 32 + 8 * fq;
                    const f32x4 v0 = acc[ai][bj][m][0], v1 = acc[ai][bj][m][1];
                    u32x4 w; w.x = cvt_pk_bf16(v0[0], v0[1]); w.y = cvt_pk_bf16(v0[2], v0[3]); w.z = cvt_pk_bf16(v1[0], v1[1]); w.w = cvt_pk_bf16(v1[2], v1[3]);
                    bf16_t* p;
                    if (u.pn < 4) { const int b = row >> 11, l = row & 2047, g = col >> 4, p0 = col & 15; p = U + ((size_t)((b * 64 + g) * 2048 + l)) * 16 + p0; }
                    else p = GB + (size_t)row * 3072 + (col - 1024);
                    *(u32x4*)p = w; } }
    }
};
struct EpiGlu {
    static constexpr bool PERM = true, AFTER_DRAIN = false;
    const bf16_t* Y; bf16_t* YG; int ld;
    __device__ __forceinline__ void operator()(const f32x4 (&acc)[2][2][4][2], const Unit& u, int wr, int wc, int fr, int fq) const {
        const int row0 = u.pm * BM + wr * 64 + fr;
#pragma unroll
        for (int ai = 0; ai < 2; ++ai)
#pragma unroll
            for (int m = 0; m < 4; ++m) { const int row = row0 + ai * HALF + m * 16;
#pragma unroll
                for (int bj = 0; bj < 2; ++bj) { const size_t off = (size_t)row * ld + u.pn * BM + bj * HALF + wc * 32 + 8 * fq;
                    const u32x4 yv = *(const u32x4*)(Y + off);
                    const f32x4 v0 = acc[ai][bj][m][0], v1 = acc[ai][bj][m][1];
                    float o[8];
                    o[0] = __uint_as_float(yv.x << 16) * sigmoid_f(v0[0]); o[1] = __uint_as_float(yv.x & 0xffff0000u) * sigmoid_f(v0[1]);
                    o[2] = __uint_as_float(yv.y << 16) * sigmoid_f(v0[2]); o[3] = __uint_as_float(yv.y & 0xffff0000u) * sigmoid_f(v0[3]);
                    o[4] = __uint_as_float(yv.z << 16) * sigmoid_f(v1[0]); o[5] = __uint_as_float(yv.z & 0xffff0000u) * sigmoid_f(v1[1]);
                    o[6] = __uint_as_float(yv.w << 16) * sigmoid_f(v1[2]); o[7] = __uint_as_float(yv.w & 0xffff0000u) * sigmoid_f(v1[3]);
                    u32x4 w; w.x = cvt_pk_bf16(o[0], o[1]); w.y = cvt_pk_bf16(o[2], o[3]); w.z = cvt_pk_bf16(o[4], o[5]); w.w = cvt_pk_bf16(o[6], o[7]);
                    *(u32x4*)(YG + off) = w; } }
    }
};

template <class Epi, class Sched, bool ALIGN_EPI = false, bool SP2 = false>
__device__ __forceinline__ void gemm_phase(PG8_LAS unsigned char* lds, const Gemm g, const Sched& S, const Epi& E, const int wid_in  ) {
    int m1_ = -1; asm volatile("" : "+s"(m1_)); int tid_ = wid_in * 64 + (int)__builtin_amdgcn_mbcnt_hi((unsigned)m1_, __builtin_amdgcn_mbcnt_lo((unsigned)m1_, 0u)); asm volatile("" : "+v"(tid_));
    const int tid = tid_, wid = __builtin_amdgcn_readfirstlane(tid >> 6), lane = tid & 63, wr = wid >> 2, wc = wid & 3, fr = lane & 15, fq = lane >> 4;
    int K_ = g.K; asm volatile("" : "+s"(K_));
    const int K = K_, nt = K / BK;
    unsigned voffA[2], voffB[2];
#pragma unroll
    for (int i = 0; i < 2; ++i) { int R, C; stage_rc(tid * 16 + i * 8192, R, C); const int Rb = Epi::PERM ? ((R & ~31) + perm32(R & 31)) : R;
        voffA[i] = (unsigned)(R * K + C) * 2u; voffB[i] = (unsigned)(Rb * K + C) * 2u; }
    const size_t kstep = (size_t)(BK * 2);
    const size_t hstep = (size_t)HALF * K * 2;
    const size_t tstep = 2 * hstep;
    const unsigned ldsw = (unsigned)wid * 1024u;
    const int aoff = lds_byte(wr * 64 + fr, fq * 8), boff = lds_byte(wc * 32 + fr, fq * 8);
#define PG8_SA(b, h) (((b) * 2 + (h)) * HTB)
#define PG8_SB(b, h) ((4 + (b) * 2 + (h)) * HTB)
#define PG8_STAGE(bufoff, gbase, voff) do { _Pragma("unroll") for (int _i = 0; _i < 2; ++_i) \
        __builtin_amdgcn_global_load_lds((const unsigned*)((const char*)(gbase) + (voff)[_i]), (PG8_LAS unsigned*)(lds + (bufoff) + ldsw + _i * 8192), 16, 0, 0); } while (0)
#define PG8_LDA(dst, b, h) do { _Pragma("unroll") for (int m = 0; m < 4; ++m) _Pragma("unroll") for (int k = 0; k < 2; ++k) dst[m][k] = *(const PG8_LAS bf16x8*)(lds + PG8_SA(b, h) + aoff + m * 2048 + k * 1024); } while (0)
#define PG8_LDB(dst, b, h) do { _Pragma("unroll") for (int n = 0; n < 2; ++n) _Pragma("unroll") for (int k = 0; k < 2; ++k) dst[n][k] = *(const PG8_LAS bf16x8*)(lds + PG8_SB(b, h) + boff + n * 2048 + k * 1024); } while (0)
#define PG8_MMA(ai, bj, At, Bt) do { __builtin_amdgcn_s_setprio(1); _Pragma("unroll") for (int m = 0; m < 4; ++m) _Pragma("unroll") for (int n = 0; n < 2; ++n) _Pragma("unroll") for (int k = 0; k < 2; ++k) \
        acc[ai][bj][m][n] = __builtin_amdgcn_mfma_f32_16x16x32_bf16(Bt[n][k], At[m][k], acc[ai][bj][m][n], 0, 0, 0); __builtin_amdgcn_s_setprio(0); } while (0)
#define PG8_WAIT_V(n) asm volatile("s_waitcnt vmcnt(" #n ")" ::: "memory")
#define PG8_WAIT_L(n) asm volatile("s_waitcnt lgkmcnt(" #n ")" ::: "memory")
#define PG8_BAR __builtin_amdgcn_s_barrier()
#define PG8_SCHED __builtin_amdgcn_sched_barrier(0)
    Unit cur, nxt; int ui = 0;
    if (!S.next(0, cur)) return;
    f32x4 acc[2][2][4][2];
#pragma unroll
    for (int a = 0; a < 2; ++a)
#pragma unroll
        for (int b = 0; b < 2; ++b)
#pragma unroll
            for (int m = 0; m < 4; ++m)
#pragma unroll
                for (int n = 0; n < 2; ++n) acc[a][b][m][n] = (f32x4){0.f, 0.f, 0.f, 0.f};
    bf16x8 At[4][2], B0[2][2], B1[2][2];
    const char* cA = (const char*)g.A + (size_t)cur.pm * tstep; const char* cB = (const char*)g.Bt + (size_t)cur.pn * tstep;
    S.a_ready(cur);
    if constexpr (SP2) {
        PG8_STAGE(PG8_SB(0, 0), cB, voffB); PG8_STAGE(PG8_SB(0, 1), cB + hstep, voffB); PG8_STAGE(PG8_SA(0, 0), cA, voffA); PG8_STAGE(PG8_SA(0, 1), cA + hstep, voffA);
        if (wr == 1) PG8_BAR;
        PG8_WAIT_V(2); PG8_BAR;
        PG8_STAGE(PG8_SB(1, 0), cB + kstep, voffB); PG8_STAGE(PG8_SA(1, 0), cA + kstep, voffA); PG8_STAGE(PG8_SB(1, 1), cB + hstep + kstep, voffB);
        PG8_WAIT_V(6); PG8_BAR;
    } else {
        PG8_STAGE(PG8_SB(0, 0), cB, voffB); PG8_STAGE(PG8_SA(0, 0), cA, voffA); PG8_STAGE(PG8_SB(0, 1), cB + hstep, voffB); PG8_STAGE(PG8_SA(0, 1), cA + hstep, voffA);
        if (wr == 1) PG8_BAR;
        PG8_WAIT_V(4); PG8_BAR;
        PG8_STAGE(PG8_SB(1, 0), cB + kstep, voffB); PG8_STAGE(PG8_SA(1, 0), cA + kstep, voffA); PG8_STAGE(PG8_SB(1, 1), cB + hstep + kstep, voffB);
        PG8_WAIT_V(6); PG8_BAR;
    }
    for (;;) {
        const bool has_next = S.next(ui + 1, nxt);
        const char* nA = has_next ? (const char*)g.A + (size_t)nxt.pm * tstep : cA; const char* nB = has_next ? (const char*)g.Bt + (size_t)nxt.pn * tstep : cB;
        for (int t = 0; t < nt; t += 2) {
            const bool last = (t == nt - 2);
            const char* a1 = cA + (size_t)(t + 1) * kstep;
            const char* a2 = last ? nA : cA + (size_t)(t + 2) * kstep; const char* b2 = last ? nB : cB + (size_t)(t + 2) * kstep;
            const char* a3 = a2 + kstep; const char* b3 = b2 + kstep;
            if (last && has_next) S.a_ready(nxt);
            if constexpr (SP2) {
            PG8_LDB(B0, 0, 0); PG8_LDB(B1, 0, 1); PG8_SCHED; PG8_LDA(At, 0, 0); PG8_STAGE(PG8_SA(1, 1), a1 + hstep, voffA);
            PG8_WAIT_V(8); PG8_WAIT_L(0); PG8_BAR; PG8_MMA(0, 0, At, B0); PG8_MMA(0, 1, At, B1); PG8_BAR; PG8_SCHED;
            PG8_LDA(At, 0, 1); PG8_STAGE(PG8_SB(0, 0), b2, voffB); PG8_STAGE(PG8_SB(0, 1), b2 + hstep, voffB); PG8_STAGE(PG8_SA(0, 0), a2, voffA);
            PG8_WAIT_V(8); PG8_WAIT_L(0); PG8_BAR; PG8_MMA(1, 0, At, B0); PG8_MMA(1, 1, At, B1); PG8_BAR; PG8_SCHED;
            PG8_LDB(B0, 1, 0); PG8_LDB(B1, 1, 1); PG8_SCHED; PG8_LDA(At, 1, 0); PG8_STAGE(PG8_SA(0, 1), a2 + hstep, voffA);
            PG8_WAIT_V(8); PG8_WAIT_L(0); PG8_BAR; PG8_MMA(0, 0, At, B0); PG8_MMA(0, 1, At, B1); PG8_BAR; PG8_SCHED;
            PG8_LDA(At, 1, 1); PG8_STAGE(PG8_SB(1, 0), b3, voffB); PG8_STAGE(PG8_SB(1, 1), b3 + hstep, voffB); PG8_STAGE(PG8_SA(1, 0), a3, voffA);
            PG8_WAIT_V(8); PG8_WAIT_L(0); PG8_BAR; PG8_MMA(1, 0, At, B0); PG8_MMA(1, 1, At, B1); PG8_BAR; PG8_SCHED;
            } else {
            PG8_LDB(B0, 0, 0); PG8_SCHED; PG8_LDA(At, 0, 0); PG8_STAGE(PG8_SA(1, 1), a1 + hstep, voffA);
            PG8_WAIT_L(8); PG8_BAR; PG8_WAIT_L(0); PG8_MMA(0, 0, At, B0); PG8_BAR; PG8_SCHED;
            PG8_LDB(B1, 0, 1); PG8_STAGE(PG8_SB(0, 0), b2, voffB);
            PG8_BAR; PG8_WAIT_L(0); PG8_MMA(0, 1, At, B1); PG8_BAR;
            PG8_LDA(At, 0, 1); PG8_STAGE(PG8_SA(0, 0), a2, voffA);
            PG8_BAR; PG8_WAIT_L(0); PG8_MMA(1, 0, At, B0); PG8_BAR; PG8_SCHED;
            PG8_STAGE(PG8_SB(0, 1), b2 + hstep, voffB);
            PG8_WAIT_V(6); PG8_BAR; PG8_MMA(1, 1, At, B1); PG8_BAR;
            PG8_LDB(B0, 1, 0); PG8_SCHED; PG8_LDA(At, 1, 0); PG8_STAGE(PG8_SA(0, 1), a2 + hstep, voffA);
            PG8_WAIT_L(8); PG8_BAR; PG8_WAIT_L(0); PG8_MMA(0, 0, At, B0); PG8_BAR; PG8_SCHED;
            PG8_LDB(B1, 1, 1); PG8_STAGE(PG8_SB(1, 0), b3, voffB);
            PG8_BAR; PG8_WAIT_L(0); PG8_MMA(0, 1, At, B1); PG8_BAR;
            PG8_LDA(At, 1, 1); PG8_STAGE(PG8_SA(1, 0), a3, voffA);
            PG8_BAR; PG8_WAIT_L(0); PG8_MMA(1, 0, At, B0); PG8_BAR; PG8_SCHED;
            PG8_STAGE(PG8_SB(1, 1), b3 + hstep, voffB);
            PG8_WAIT_V(6); PG8_BAR; PG8_MMA(1, 1, At, B1); PG8_BAR;
            }
        }
        if constexpr (ALIGN_EPI) { if (wr == 0) PG8_BAR; }
        if constexpr (!Epi::AFTER_DRAIN) { E(acc, cur, wr, wc, fr, fq); S.done(cur); }
        if (!has_next) break;
#pragma unroll
        for (int a = 0; a < 2; ++a)
#pragma unroll
            for (int b = 0; b < 2; ++b)
#pragma unroll
                for (int m = 0; m < 4; ++m)
#pragma unroll
                    for (int n = 0; n < 2; ++n) acc[a][b][m][n] = (f32x4){0.f, 0.f, 0.f, 0.f};
        cur = nxt; cA = nA; cB = nB; ++ui;
        if constexpr (ALIGN_EPI) { if (wr == 1) PG8_BAR; }
    }
    PG8_WAIT_V(0);
    if constexpr (!ALIGN_EPI) { if (wr == 0) PG8_BAR; }
    PG8_BAR;
    if constexpr (Epi::AFTER_DRAIN) { E.fused(acc, cur, wr, wc, fr, fq, lds, wid, lane); S.done(cur); }
#undef PG8_SA
#undef PG8_SB
#undef PG8_STAGE
#undef PG8_LDA
#undef PG8_LDB
#undef PG8_MMA
#undef PG8_WAIT_V
#undef PG8_WAIT_L
#undef PG8_BAR
#undef PG8_SCHED
}
}
#define GAS __attribute__((address_space(1)))
#define LAS __attribute__((address_space(3)))
typedef unsigned short bf16;
typedef unsigned v4u __attribute__((ext_vector_type(4)));
typedef float f32x4 __attribute__((ext_vector_type(4)));
typedef short bf16x8 __attribute__((ext_vector_type(8)));
typedef GAS unsigned gu32;
typedef GAS unsigned long long gu64;
#define RLX_AGENT __ATOMIC_RELAXED, __HIP_MEMORY_SCOPE_AGENT
#define LDS_WAIT() asm volatile("s_waitcnt lgkmcnt(0)" ::: "memory")
#define VM_WAIT() asm volatile("s_waitcnt vmcnt(0)" ::: "memory")
__device__ __forceinline__ unsigned long long rt() { return __builtin_amdgcn_s_memrealtime(); }
__device__ __forceinline__ unsigned f2bf(float f) { unsigned u = __builtin_bit_cast(unsigned, f); return (u + 0x7fffu + ((u >> 16) & 1u)) >> 16; }
__device__ __forceinline__ unsigned pk2(float lo, float hi) { return f2bf(lo) | (f2bf(hi) << 16); }

#define XB_TMO      128
#define XB_XCNT(j)  (256  + 64 * (j))
#define XB_XSUB(j)  (1280 + 64 * (j))
#define XB_XGEN(j)  (2304 + 64 * (j))
#define XB_TOP      3328
#define XB_TOPGEN   3392
#define XCD_BAR_WORDS 3456
#define XB_SPIN_CAP (1u << 18)

__device__ __forceinline__ unsigned xb_ld(unsigned* p)              { return __hip_atomic_load(p, __ATOMIC_RELAXED, __HIP_MEMORY_SCOPE_AGENT); }
__device__ __forceinline__ unsigned xb_add(unsigned* p, unsigned v) { return __hip_atomic_fetch_add(p, v, __ATOMIC_RELAXED, __HIP_MEMORY_SCOPE_AGENT); }
__device__ __forceinline__ unsigned xb_xcc_id() { return (unsigned)__builtin_amdgcn_s_getreg((3 << 11) | 20) & 0xFu; }
#define XB_SPIN(cond, bar) do { unsigned _sp = 0; while (cond) { __builtin_amdgcn_s_sleep(1); \
    if ((++_sp & 255u) == 0u) { if (xb_ld(&(bar)[XB_TMO])) break; if (_sp > XB_SPIN_CAP) { atomicAdd(&(bar)[XB_TMO], 1u); break; } } } } while (0)

struct XcdBarrier {
    unsigned* bar; unsigned x;
    volatile LAS unsigned* st;
};

__device__ __forceinline__ XcdBarrier xcd_barrier_post(unsigned* bar, volatile LAS unsigned* st) {
    XcdBarrier b; b.bar = bar; b.x = xb_xcc_id(); b.st = st;
    if (threadIdx.x == 0) (void)xb_add(&bar[XB_XCNT(b.x)], 1u);
    return b;
}
__device__ __forceinline__ void xcd_barrier_complete(unsigned* bar, unsigned x, unsigned& nloc, unsigned& nx) {
    const unsigned G = gridDim.x * gridDim.y * gridDim.z;
    unsigned sum, cnt, mine, sp = 0u;
    for (;;) {
        sum = 0u; cnt = 0u; mine = 0u;
#pragma unroll
        for (unsigned j = 0; j < 16; ++j) { const unsigned c = xb_ld(&bar[XB_XCNT(j)]); sum += c; cnt += (c > 0u) ? 1u : 0u; mine = (j == x) ? c : mine; }
        if (sum == G) break;
        __builtin_amdgcn_s_sleep(1);
        if ((++sp & 255u) == 0u) { if (xb_ld(&bar[XB_TMO])) break; if (sp > XB_SPIN_CAP) { atomicAdd(&bar[XB_TMO], 1u); break; } }
    }
    nloc = mine > 0u ? mine : 1u; nx = cnt > 0u ? cnt : 1u;
}

__device__ __forceinline__ void xcd_barrier(const XcdBarrier& b) {
    asm volatile("s_waitcnt vmcnt(0)" ::: "memory");
    __syncthreads();
    if (threadIdx.x == 0) {
        unsigned* bar = b.bar;
        __builtin_amdgcn_s_waitcnt(0);
        unsigned nloc = b.st[0], nx = b.st[1];
        if (nloc == 0u) { xcd_barrier_complete(bar, b.x, nloc, nx); b.st[0] = nloc; b.st[1] = nx; }
        const unsigned old = xb_add(&bar[XB_XSUB(b.x)], 1u);
        const unsigned gen = old / nloc;
        if (old + 1u == (gen + 1u) * nloc) {
            __builtin_amdgcn_fence(__ATOMIC_RELEASE, "agent");
            asm volatile("s_waitcnt vmcnt(0)" ::: "memory");
            const unsigned og = xb_add(&bar[XB_TOP], 1u);
            const unsigned tg = og / nx;
            if (og + 1u == (tg + 1u) * nx) xb_add(&bar[XB_TOPGEN], 1u);
            else XB_SPIN(xb_ld(&bar[XB_TOPGEN]) == tg, bar);
            __builtin_amdgcn_fence(__ATOMIC_ACQUIRE, "agent");
            xb_add(&bar[XB_XGEN(b.x)], 1u);
            asm volatile("s_waitcnt vmcnt(0)" ::: "memory");
        } else {
            XB_SPIN(xb_ld(&bar[XB_XGEN(b.x)]) == gen, bar);
            __builtin_amdgcn_fence(__ATOMIC_ACQUIRE, "agent");
            asm volatile("s_waitcnt vmcnt(0)" ::: "memory");
        }
    }
    __syncthreads();
}

constexpr int NWAVES = 8;
constexpr int BATCH = 4, SEQ = 2048, DM = 2048, DFF = 5632, DEPTH = 4, DS5 = 1024, DCONV = 1024, DIN = 4096, S5G = 64, S5P = 16, S5N = 64;
constexpr int M = BATCH * SEQ;
constexpr float LN_EPS = 1e-5f, RMS_EPS = 1e-6f, DN_ALPHA = 1.6817928305074292f;
#ifndef MK_PER_PHASE
#define MK_PER_PHASE 0
#endif
#ifndef S5_NAIVE
#define S5_NAIVE 0
#endif
constexpr int NPHASE = 1 + 8 * 3 + 4 * 6;

constexpr size_t MiB = 1u << 20;
constexpr size_t WS_CTL = 0, CTL_ZERO_BYTES = 1 * MiB;
constexpr size_t WS_W = 1 * MiB;
constexpr size_t SZ_WGU = (size_t)2 * DFF * DM * 2, SZ_WD = (size_t)DM * DFF * 2, SZ_WIN = (size_t)DIN * DM * 2, SZ_WGLU = (size_t)DS5 * DS5 * 2, SZ_WOUT = (size_t)DM * DM * 2;
constexpr size_t OFF_WGU1 = 0, OFF_WD1 = OFF_WGU1 + SZ_WGU, OFF_WGU2 = OFF_WD1 + SZ_WD, OFF_WD2 = OFF_WGU2 + SZ_WGU, OFF_WIN = OFF_WD2 + SZ_WD, OFF_WGLU = OFF_WIN + SZ_WIN, OFF_WOUT = OFF_WGLU + SZ_WGLU;
constexpr size_t SZ_LAYER = OFF_WOUT + SZ_WOUT;
constexpr size_t WS_XF = WS_W + DEPTH * SZ_LAYER;
constexpr size_t WS_V = WS_XF + (size_t)M * DM * 4;
constexpr size_t WS_XB = WS_V + (size_t)M * DM * 4;
constexpr size_t WS_H = WS_XB + (size_t)M * DM * 2;
constexpr size_t WS_U = WS_H + (size_t)M * DFF * 2;
constexpr size_t WS_GB = WS_U + (size_t)M * DS5 * 2;
constexpr size_t WS_Y = WS_GB + (size_t)M * 3072 * 2;
constexpr size_t WS_YG = WS_Y + (size_t)M * DS5 * 2;
constexpr size_t WS_YZ = WS_YG + (size_t)M * DS5 * 2;
constexpr size_t WS_END = WS_YZ + (size_t)M * DM * 2;
constexpr int CW_TMO = 0, CW_CODE = 1, CW_BAR = 4096;

constexpr int RING_OFF = 0, RING_BYTES = 131072;
constexpr int LDS_BYTES = 147456;
constexpr int MISC_OFF = LDS_BYTES - 512;

__device__ __forceinline__ float bflo(unsigned w) { return __uint_as_float(w << 16); }
__device__ __forceinline__ float bfhi(unsigned w) { return __uint_as_float(w & 0xffff0000u); }

struct Frame {
    LAS unsigned char* lds;
    volatile LAS unsigned* MISC;
    gu32* ctl;
    int tid, lane, wave, vcu, G;
    const float* const* in;
};
struct Args { const float* in[28]; float* out; unsigned char* ws; int ph_lo, ph_hi, use_bar, pad; };
__device__ __forceinline__ int opq(int i) { asm volatile("" : "+s"(i)); return i; }

__device__ __forceinline__ float wave_sum(float v, int lane) {
#pragma unroll
    for (int o = 1; o < 64; o <<= 1) v += __int_as_float(__builtin_amdgcn_ds_bpermute((lane ^ o) << 2, __float_as_int(v)));
    return v;
}
__device__ __forceinline__ void transpose_item(const float* W, int K, int N, bf16* WT, int k0, int n0, int drow, LAS float* scr, int lane) {
#pragma unroll 8
    for (int i = 0; i < 32; ++i) { const int kk = 2 * i + (lane >> 5); scr[kk * 33 + (lane & 31)] = W[(size_t)(k0 + kk) * N + n0 + (lane & 31)]; }
    LDS_WAIT(); asm volatile("" ::: "memory");
    const int c = lane & 7;
#pragma unroll
    for (int j = 0; j < 4; ++j) { const int n = (lane >> 3) + 8 * j; const LAS float* s = scr + (8 * c) * 33 + n;
        v4u o; o.x = pk2(s[0 * 33], s[1 * 33]); o.y = pk2(s[2 * 33], s[3 * 33]); o.z = pk2(s[4 * 33], s[5 * 33]); o.w = pk2(s[6 * 33], s[7 * 33]);
        *(GAS v4u*)(WT + (size_t)(drow + n) * K + k0 + 8 * c) = o; }
    LDS_WAIT(); asm volatile("" ::: "memory");
}
__device__ __forceinline__ void transpose_matrix(const float* W, int K, int N, bf16* WT, int mode, LAS float* scr, int gw, int NGW, int lane) {
    const int nblk = N / 32, nitems = (K / 64) * nblk;
    for (int it = gw; it < nitems; it += NGW) {
        const int kb = it / nblk, nb = it % nblk, n0 = 32 * nb;
        const int drow = (mode == 0) ? n0 : ((n0 >> 7) * 256 + (n0 & 127) + (mode == 2 ? 128 : 0));
        transpose_item(W, K, N, WT, 64 * kb, n0, drow, scr, lane);
    }
}

__device__ __forceinline__ void ln_row(const float* vrow, const float* g, const float* b, float* xf, bf16* xb, int lane) {
    const GAS f32x4* xr = (const GAS f32x4*)vrow + lane;
    f32x4 v[8]; float s = 0.f;
#pragma unroll
    for (int j = 0; j < 8; ++j) { v[j] = xr[64 * j]; s += (v[j].x + v[j].y) + (v[j].z + v[j].w); }
    const float mean = wave_sum(s, lane) * (1.f / DM); float s2 = 0.f;
#pragma unroll
    for (int j = 0; j < 8; ++j) { v[j] = v[j] - mean; s2 += (v[j].x * v[j].x + v[j].y * v[j].y) + (v[j].z * v[j].z + v[j].w * v[j].w); }
    const float rstd = 1.f / sqrtf(wave_sum(s2, lane) * (1.f / DM) + LN_EPS);
    GAS f32x4* of = (GAS f32x4*)xf + lane; GAS unsigned long long* ob = (GAS unsigned long long*)xb + lane;
    const GAS f32x4* gr = (const GAS f32x4*)g + lane; const GAS f32x4* br = (const GAS f32x4*)b + lane;
#pragma unroll
    for (int j = 0; j < 8; ++j) { const f32x4 o = v[j] * rstd * gr[64 * j] + br[64 * j]; of[64 * j] = o;
        ob[64 * j] = (unsigned long long)pk2(o.x, o.y) | ((unsigned long long)pk2(o.z, o.w) << 32); }
}

__device__ __forceinline__ float gelu_tanh(float x) {
    const float z2 = 1.5957691216057308f * (x + 0.044715f * x * x * x);
    return x * __builtin_amdgcn_rcpf(1.0f + __builtin_amdgcn_exp2f(z2 * -1.4426950408889634f));
}

__device__ __forceinline__ void sincos_f(float x, float& s, float& c) {
    const float k = rintf(x * 0.63661977236758134f);
    float r = fmaf(-k, 1.5707962513e+00f, x); r = fmaf(-k, 7.5497894159e-08f, r); r = fmaf(-k, 5.3903029534e-15f, r);
    const float r2 = r * r;
    float sp = fmaf(r2, 2.7557314297e-06f, -1.9841270114e-04f); sp = fmaf(sp, r2, 8.3333337680e-03f); sp = fmaf(sp, r2, -1.6666667163e-01f); sp = fmaf(sp * r2, r, r);
    float cp = fmaf(r2, 2.4433157118e-05f, -1.3887316255e-03f); cp = fmaf(cp, r2, 4.1666645683e-02f); cp = fmaf(cp, r2, -0.5f); cp = fmaf(cp, r2, 1.0f);
    const int q = (int)k & 3;
    const float ss = (q & 1) ? cp : sp, cc = (q & 1) ? sp : cp;
    s = (q & 2) ? -ss : ss; c = ((q + 1) & 2) ? -cc : cc;
}

#if S5_NAIVE
__device__ __forceinline__ void s5_naive_unit(Frame& F, const Args& A, int layer, int b, int g, const bf16* U, bf16* Y, const int tid) {
    const int lane = tid & 63;
    typedef float f32x2v __attribute__((ext_vector_type(2)));
    LAS f32x2v* Cs = (LAS f32x2v*)(F.lds + RING_OFF);
    LAS f32x2v* Ss = (LAS f32x2v*)(F.lds + RING_OFF + 8192);
    LAS float* Us = (LAS float*)(F.lds + RING_OFF + 8192 + 32768);
    LAS float* Dd = (LAS float*)(F.lds + RING_OFF + 8192 + 32768 + 4096);
    const int lg = layer * S5G + g;
    const float* c_re = A.in[opq(12)] + (size_t)lg * S5P * S5N; const float* c_im = A.in[opq(13)] + (size_t)lg * S5P * S5N;
    for (int i = tid; i < S5P * S5N; i += NWAVES * 64) Cs[i] = (f32x2v){c_re[i], c_im[i]};
    if (tid < 16) Dd[tid] = A.in[opq(14)][lg * S5P + tid];
    float are = 0.f, aim = 0.f, bbr[16], bbi[16], sre = 0.f, sim = 0.f;
#pragma unroll
    for (int p = 0; p < 16; ++p) { bbr[p] = 0.f; bbi[p] = 0.f; }
    if (F.wave == 0) {
        const int n = lane; const float lre = A.in[opq(7)][lg * S5N + n], lim = A.in[opq(8)][lg * S5N + n], dt = expf(A.in[opq(9)][lg]);
        const float mag = expf(lre * dt); float sn, cs; sincos_f(lim * dt, sn, cs);
        are = mag * cs; aim = mag * sn;
        const float den = lre * lre + lim * lim, nr = are - 1.0f, ni = aim, qre = (nr * lre + ni * lim) / den, qim = (ni * lre - nr * lim) / den;
        const float* bre = A.in[opq(10)] + ((size_t)lg * S5N + n) * S5P; const float* bim = A.in[opq(11)] + ((size_t)lg * S5N + n) * S5P;
#pragma unroll
        for (int p = 0; p < 16; ++p) { const float br = bre[p], bi = bim[p]; bbr[p] = qre * br - qim * bi; bbi[p] = qre * bi + qim * br; }
    }
    const bf16* Ub = U + ((size_t)(b * S5G + g) * SEQ) * S5P;
    for (int blk = 0; blk < SEQ / 64; ++blk) {
        __syncthreads();
        for (int i = tid; i < 64 * 16; i += NWAVES * 64) Us[i] = __uint_as_float(((unsigned)Ub[(size_t)blk * 1024 + i]) << 16);
        __syncthreads();
        if (F.wave == 0) {
            for (int t = 0; t < 64; ++t) {
                float bur = 0.f, bui = 0.f;
#pragma unroll
                for (int p = 0; p < 16; ++p) { const float uv = Us[t * 16 + p]; bur = fmaf(bbr[p], uv, bur); bui = fmaf(bbi[p], uv, bui); }
                const float nre = are * sre - aim * sim + bur, nim = are * sim + aim * sre + bui;
                sre = nre; sim = nim;
                Ss[t * 64 + lane] = (f32x2v){sre, sim};
            }
        }
        __syncthreads();
#pragma unroll
        for (int r = 0; r < 2; ++r) {
            const int o = tid + r * 512, t = o >> 4, p = o & 15;
            float acc = Dd[p] * Us[t * 16 + p];
#pragma unroll 4
            for (int n = 0; n < 64; ++n) { const f32x2v c = Cs[p * 64 + n], s = Ss[t * 64 + n]; acc = fmaf(c.x, s.x, acc); acc = fmaf(-c.y, s.y, acc); }
            Y[(size_t)(b * SEQ + blk * 64 + t) * DS5 + g * S5P + p] = (bf16)f2bf(gelu_tanh(acc));
        }
    }
    __syncthreads();
}
#endif

__device__ __forceinline__ void unpack8(const v4u w, float (&o)[8]) {
    o[0] = bflo(w.x); o[1] = bfhi(w.x); o[2] = bflo(w.y); o[3] = bfhi(w.y); o[4] = bflo(w.z); o[5] = bfhi(w.z); o[6] = bflo(w.w); o[7] = bfhi(w.w);
}
__device__ __forceinline__ v4u pack8(const float (&o)[8]) { v4u w; w.x = pk2(o[0], o[1]); w.y = pk2(o[2], o[3]); w.z = pk2(o[4], o[5]); w.w = pk2(o[6], o[7]); return w; }
__device__ __forceinline__ void conv_rows(const Args& A, int layer, const bf16* GB, bf16* YZ, int gw, int NGW, int lane) {
    const float* cw = A.in[opq(16)] + (size_t)layer * 3 * DCONV; const float* cb = A.in[opq(17)] + (size_t)layer * DCONV; const float* gc = A.in[opq(19)] + (size_t)layer * DCONV;
    for (int grp = gw; grp < M / 4; grp += NGW) {
        const int row0 = grp * 4, l0 = row0 & (SEQ - 1);
        float vm2[2][8], vm1[2][8];
#pragma unroll
        for (int j = 0; j < 2; ++j) { const int c0 = (64 * j + lane) * 8;
#pragma unroll
            for (int e = 0; e < 8; ++e) { vm2[j][e] = 0.f; vm1[j][e] = 0.f; }
            if (l0 >= 2) {
                float a[8], h[8];
                unpack8(*(const GAS v4u*)(GB + (size_t)(row0 - 2) * 3072 + 1024 + c0), a); unpack8(*(const GAS v4u*)(GB + (size_t)(row0 - 2) * 3072 + 2048 + c0), h);
#pragma unroll
                for (int e = 0; e < 8; ++e) vm2[j][e] = a[e] * h[e];
                unpack8(*(const GAS v4u*)(GB + (size_t)(row0 - 1) * 3072 + 1024 + c0), a); unpack8(*(const GAS v4u*)(GB + (size_t)(row0 - 1) * 3072 + 2048 + c0), h);
#pragma unroll
                for (int e = 0; e < 8; ++e) vm1[j][e] = a[e] * h[e];
            } }
#pragma unroll 1
        for (int r = 0; r < 4; ++r) {
            const size_t ro = (size_t)(row0 + r) * 3072;
            float z[2][8]; float ss = 0.f;
#pragma unroll
            for (int j = 0; j < 2; ++j) { const int c0 = (64 * j + lane) * 8;
                float gb[8], a[8], h[8];
                unpack8(*(const GAS v4u*)(GB + ro + c0), gb); unpack8(*(const GAS v4u*)(GB + ro + 1024 + c0), a); unpack8(*(const GAS v4u*)(GB + ro + 2048 + c0), h);
                const f32x4 w0a = *(const GAS f32x4*)(cw + c0), w0b = *(const GAS f32x4*)(cw + c0 + 4), w1a = *(const GAS f32x4*)(cw + DCONV + c0), w1b = *(const GAS f32x4*)(cw + DCONV + c0 + 4);
                const f32x4 w2a = *(const GAS f32x4*)(cw + 2 * DCONV + c0), w2b = *(const GAS f32x4*)(cw + 2 * DCONV + c0 + 4), bba = *(const GAS f32x4*)(cb + c0), bbb = *(const GAS f32x4*)(cb + c0 + 4);
#pragma unroll
                for (int e = 0; e < 8; ++e) { const float v0 = a[e] * h[e]; const float w0 = e < 4 ? w0a[e & 3] : w0b[e & 3], w1 = e < 4 ? w1a[e & 3] : w1b[e & 3], w2 = e < 4 ? w2a[e & 3] : w2b[e & 3], bb = e < 4 ? bba[e & 3] : bbb[e & 3];
                    z[j][e] = gb[e] * (bb + w0 * vm2[j][e] + w1 * vm1[j][e] + w2 * v0); ss += z[j][e] * z[j][e]; vm2[j][e] = vm1[j][e]; vm1[j][e] = v0; } }
            const float rs = 1.f / sqrtf(wave_sum(ss, lane) * (1.f / DCONV) + RMS_EPS);
#pragma unroll
            for (int j = 0; j < 2; ++j) { const int c0 = (64 * j + lane) * 8; float o[8];
                const f32x4 ga = *(const GAS f32x4*)(gc + c0), gb4 = *(const GAS f32x4*)(gc + c0 + 4);
#pragma unroll
                for (int e = 0; e < 8; ++e) o[e] = z[j][e] * rs * (e < 4 ? ga[e & 3] : gb4[e & 3]);
                *(GAS v4u*)(YZ + (size_t)(row0 + r) * DM + DS5 + c0) = pack8(o); }
        }
    }
}
__device__ __forceinline__ void ynorm_rows(const Args& A, int layer, const bf16* YG, bf16* YZ, int gw, int NGW, int lane) {
    const float* gs = A.in[opq(18)] + (size_t)layer * DS5;
    float gg[2][8];
#pragma unroll
    for (int j = 0; j < 2; ++j) { const int c0 = (64 * j + lane) * 8;
#pragma unroll
        for (int e = 0; e < 8; ++e) gg[j][e] = gs[c0 + e]; }
    for (int row = gw; row < M; row += NGW) {
        float y[2][8]; float ss = 0.f;
#pragma unroll
        for (int j = 0; j < 2; ++j) { unpack8(*(const GAS v4u*)(YG + (size_t)row * DS5 + (64 * j + lane) * 8), y[j]);
#pragma unroll
            for (int e = 0; e < 8; ++e) ss += y[j][e] * y[j][e]; }
        const float rs = 1.f / sqrtf(wave_sum(ss, lane) * (1.f / DS5) + RMS_EPS);
#pragma unroll
        for (int j = 0; j < 2; ++j) { float o[8];
#pragma unroll
            for (int e = 0; e < 8; ++e) o[e] = y[j][e] * rs * gg[j][e];
            *(GAS v4u*)(YZ + (size_t)row * DM + (64 * j + lane) * 8) = pack8(o); }
    }
}

namespace s5f {
typedef short bf16x8 __attribute__((ext_vector_type(8)));
typedef float f32x16 __attribute__((ext_vector_type(16)));
typedef float f32x2v __attribute__((ext_vector_type(2)));
constexpr int O_V8 = 0, O_F = 32768, O_E = 40960, O_W8 = 49152, O_Z = 49152, ZROW = 272, ZWAVE = 32 * ZROW  ;
constexpr int O_SCR = 81920, O_P = O_SCR, O_C = O_P + 10 * 64 * 8, O_BB = O_C + 16 * 64 * 8, O_K = O_BB + 64 * 16 * 8, O_D = O_K + 8 * 16 * 16 * 4, O_END = O_Z + 8 * ZWAVE;
static_assert(O_D + 64 <= O_END && O_END <= 131072, "S5 LDS map");
__device__ __forceinline__ int tau(int c) { return 16 * ((c >> 2) & 1) + 4 * (c >> 3) + (c & 3); }
__device__ __forceinline__ f32x2v cmul(f32x2v a, f32x2v b) { return (f32x2v){a.x * b.x - a.y * b.y, a.x * b.y + a.y * b.x}; }

__device__ __forceinline__ void unit(LAS unsigned char* L, const Args& A, int layer, int b, int g, const bf16* U, bf16* Y, const int tid, const int wave) {
    const int lane = tid & 63, c = lane & 31, h = lane >> 5;
    const int lg = layer * S5G + g;
    LAS f32x2v* Ps = (LAS f32x2v*)(L + O_P); LAS f32x2v* Cs = (LAS f32x2v*)(L + O_C); LAS f32x2v* Bs = (LAS f32x2v*)(L + O_BB); LAS float* Ks = (LAS float*)(L + O_K); LAS float* Ds = (LAS float*)(L + O_D);
    {
        const float dt = expf(A.in[opq(9)][lg]);
        const float* lre_p = A.in[opq(7)] + lg * S5N; const float* lim_p = A.in[opq(8)] + lg * S5N;
        for (int idx = tid; idx < 640; idx += NWAVES * 64) { const int d = idx >> 6, n = idx & 63; const float dv = (d < 9) ? (float)d : 128.0f;
            const float mag = expf(lre_p[n] * dt * dv); float sn, cs; sincos_f(lim_p[n] * dt * dv, sn, cs); Ps[idx] = (f32x2v){mag * cs, mag * sn}; }
        const float* cre = A.in[opq(12)] + (size_t)lg * S5P * S5N; const float* cim = A.in[opq(13)] + (size_t)lg * S5P * S5N;
        for (int idx = tid; idx < S5P * S5N; idx += NWAVES * 64) Cs[idx] = (f32x2v){cre[idx], cim[idx]};
        const float* bre = A.in[opq(10)] + (size_t)lg * S5N * S5P; const float* bim = A.in[opq(11)] + (size_t)lg * S5N * S5P;
        for (int idx = tid; idx < S5N * S5P; idx += NWAVES * 64) { const int n = idx >> 4;
            const float lre = lre_p[n], lim = lim_p[n], mag = expf(lre * dt); float sn, cs; sincos_f(lim * dt, sn, cs);
            const float are = mag * cs, aim = mag * sn, den = lre * lre + lim * lim, nr = are - 1.0f, ni = aim, qre = (nr * lre + ni * lim) / den, qim = (ni * lre - nr * lim) / den;
            const float br = bre[idx], bi = bim[idx]; Bs[idx] = (f32x2v){qre * br - qim * bi, qre * bi + qim * br}; }
        if (tid < 16) Ds[tid] = A.in[opq(14)][lg * S5P + tid];
    }
    LDS_WAIT(); __syncthreads();
    for (int idx = tid; idx < 2048; idx += NWAVES * 64) {
        const int l = idx & 63, j = (idx >> 6) & 7, t4 = idx >> 9, lc = l & 31, lh = l >> 5;
        {
            const int n = 32 * (t4 >> 1) + lc; const f32x2v pw = Ps[(7 - j) * 64 + n]; float o[8];
#pragma unroll
            for (int e = 0; e < 8; ++e) { const f32x2v w = cmul(pw, Bs[n * 16 + 8 * lh + e]); o[e] = (t4 & 1) ? w.y : w.x; }
            *(LAS v4u*)(L + O_W8 + idx * 16) = pack8(o); }
        {
            const int ii = lc >> 4, p = lc & 15, i = 2 * t4 + ii; float o[8];
#pragma unroll
            for (int e2 = 0; e2 < 4; ++e2) { const int n = 8 * j + 4 * lh + e2; const f32x2v w = cmul(Cs[p * 64 + n], Ps[(i + 1) * 64 + n]); o[2 * e2] = w.x; o[2 * e2 + 1] = -w.y; }
            *(LAS v4u*)(L + O_V8 + idx * 16) = pack8(o); }
        {
            const int lag = idx >> 8, p = (idx >> 4) & 15, q = idx & 15; float acc = 0.f;
#pragma unroll 4
            for (int n = 0; n < 64; ++n) { const f32x2v w = cmul(Cs[p * 64 + n], Ps[lag * 64 + n]); const f32x2v bb = Bs[n * 16 + q]; acc = fmaf(w.x, bb.x, acc); acc = fmaf(-w.y, bb.y, acc); }
            if (lag == 0 && p == q) acc += Ds[p];
            Ks[idx] = acc; }
    }
    LDS_WAIT(); __syncthreads();
    {
        const int l = tid & 63, dI = tid >> 6, lc = l & 31, lh = l >> 5, ii = lc >> 4, p = lc & 15, lag = dI - 1 + ii; float o[8];
#pragma unroll
        for (int e = 0; e < 8; ++e) o[e] = (lag < 0) ? 0.f : Ks[(lag * 16 + p) * 16 + 8 * lh + e];
        *(LAS v4u*)(L + O_F + tid * 16) = pack8(o);
    }
    const f32x2v a8_0 = Ps[8 * 64 + c], a8_1 = Ps[8 * 64 + 32 + c], A16_0 = Ps[9 * 64 + c], A16_1 = Ps[9 * 64 + 32 + c];
    LDS_WAIT(); __syncthreads();
    const int sblk = 32 * wave + tau(c);
    const bf16* Ub = U + ((size_t)(b * S5G + g) * SEQ) * S5P;
    bf16x8 uf[8];
#pragma unroll
    for (int j = 0; j < 8; ++j) uf[j] = *(const GAS bf16x8*)(Ub + (size_t)(sblk * 8 + j) * 16 + 8 * h);
    f32x16 acc[4];
#pragma unroll
    for (int t4 = 0; t4 < 4; ++t4) {
#pragma unroll
        for (int r = 0; r < 16; ++r) acc[t4][r] = 0.f;
#pragma unroll
        for (int j = 0; j < 8; ++j) { const bf16x8 wf = *(const LAS bf16x8*)(L + O_W8 + ((t4 * 8 + j) * 64 + lane) * 16); acc[t4] = __builtin_amdgcn_mfma_f32_32x32x16_bf16(uf[j], wf, acc[t4], 0, 0, 0); }
    }
    LAS f32x2v* Es = (LAS f32x2v*)(L + O_E);
    const int blk = 2 * wave + h;
    {
        float zr = 0.f, zi = 0.f;
#pragma unroll
        for (int r = 0; r < 16; ++r) { const float nr = a8_0.x * zr - a8_0.y * zi + acc[0][r], ni = a8_0.x * zi + a8_0.y * zr + acc[1][r]; zr = nr; zi = ni; acc[0][r] = zr; acc[1][r] = zi; }
        Es[blk * 64 + c] = (f32x2v){zr, zi};
        zr = 0.f; zi = 0.f;
#pragma unroll
        for (int r = 0; r < 16; ++r) { const float nr = a8_1.x * zr - a8_1.y * zi + acc[2][r], ni = a8_1.x * zi + a8_1.y * zr + acc[3][r]; zr = nr; zi = ni; acc[2][r] = zr; acc[3][r] = zi; }
        Es[blk * 64 + 32 + c] = (f32x2v){zr, zi};
    }
    LDS_WAIT(); __syncthreads();
    LAS unsigned char* Zw = L + O_Z + wave * ZWAVE;
    {
        f32x2v cz0 = (f32x2v){0.f, 0.f}, cz1 = (f32x2v){0.f, 0.f};
#pragma unroll
        for (int bp = 0; bp < 15; ++bp) { const f32x2v e0 = Es[bp * 64 + c], e1 = Es[bp * 64 + 32 + c]; const f32x2v t0 = cmul(A16_0, cz0) + e0, t1 = cmul(A16_1, cz1) + e1; if (bp < blk) { cz0 = t0; cz1 = t1; } }
        f32x2v corr0 = cz0, corr1 = cz1, prev0 = cz0, prev1 = cz1;
#pragma unroll
        for (int r = 0; r < 16; ++r) {
            LAS unsigned* zrow = (LAS unsigned*)(Zw + (16 * h + r) * ZROW);
            zrow[c] = pk2(prev0.x, prev0.y); zrow[32 + c] = pk2(prev1.x, prev1.y);
            corr0 = cmul(a8_0, corr0); corr1 = cmul(a8_1, corr1);
            prev0 = (f32x2v){acc[0][r] + corr0.x, acc[1][r] + corr0.y}; prev1 = (f32x2v){acc[2][r] + corr1.x, acc[3][r] + corr1.y};
        }
    }
    LDS_WAIT(); asm volatile("" ::: "memory");
    bf16x8 zf[8];
#pragma unroll
    for (int k = 0; k < 8; ++k) zf[k] = *(const LAS bf16x8*)(Zw + tau(c) * ZROW + k * 32 + h * 16);
    bf16* Yb = Y + ((size_t)(b * SEQ + sblk * 8)) * DS5 + g * S5P + 4 * h;
#pragma unroll
    for (int m = 0; m < 4; ++m) {
        f32x16 y;
#pragma unroll
        for (int r = 0; r < 16; ++r) y[r] = 0.f;
#pragma unroll
        for (int j = 0; j < 2 * m + 2; ++j) { const bf16x8 ff = *(const LAS bf16x8*)(L + O_F + ((2 * m - j + 1) * 64 + lane) * 16); y = __builtin_amdgcn_mfma_f32_32x32x16_bf16(ff, uf[j], y, 0, 0, 0); }
#pragma unroll
        for (int k = 0; k < 8; ++k) { const bf16x8 vf = *(const LAS bf16x8*)(L + O_V8 + ((m * 8 + k) * 64 + lane) * 16); y = __builtin_amdgcn_mfma_f32_32x32x16_bf16(vf, zf[k], y, 0, 0, 0); }
#pragma unroll
        for (int ii = 0; ii < 2; ++ii)
#pragma unroll
            for (int pg = 0; pg < 2; ++pg) { const int r0 = 8 * ii + 4 * pg;
                typedef unsigned u32x2v __attribute__((ext_vector_type(2)));
                u32x2v w; w.x = pk2(gelu_tanh(y[r0]), gelu_tanh(y[r0 + 1])); w.y = pk2(gelu_tanh(y[r0 + 2]), gelu_tanh(y[r0 + 3]));
                *(GAS u32x2v*)(Yb + (size_t)(2 * m + ii) * DS5 + 8 * pg) = w; }
    }
    LDS_WAIT(); __syncthreads();
}
}
#ifndef P_PRO
#define P_PRO 1
#endif
#ifndef P_G1
#define P_G1 1
#endif
#ifndef P_G2
#define P_G2 1
#endif
#ifndef P_LN
#define P_LN 1
#endif
#ifndef P_G3
#define P_G3 1
#endif
#ifndef P_S5
#define P_S5 1
#endif
#ifndef P_G4
#define P_G4 1
#endif
#ifndef P_YN
#define P_YN 1
#endif
#ifndef P_G5
#define P_G5 1
#endif
#ifndef P_LN2
#define P_LN2 1
#endif
__global__ void __launch_bounds__(NWAVES * 64, 2) fwd(Args args) {
    extern __shared__ __attribute__((aligned(16))) unsigned char lds[];
    Frame F;
    F.lds = (LAS unsigned char*)lds;
    F.MISC = (volatile LAS unsigned*)(F.lds + MISC_OFF);
    F.tid = threadIdx.x; F.lane = F.tid & 63; F.wave = __builtin_amdgcn_readfirstlane(F.tid >> 6);
    F.G = gridDim.x; { const int bx = blockIdx.x; F.vcu = (F.G % 8 == 0) ? (bx % 8) * (F.G / 8) + bx / 8 : bx; }
    unsigned char* ws = args.ws;
    F.ctl = (gu32*)(ws + WS_CTL);
    for (int u = F.tid; u < (LDS_BYTES - MISC_OFF) / 4; u += NWAVES * 64) ((LAS unsigned*)(F.lds + MISC_OFF))[u] = 0u;
    __syncthreads();
    XcdBarrier bar; bar.bar = (unsigned*)(F.ctl + CW_BAR); bar.x = 0; bar.st = nullptr;
    if (args.use_bar) bar = xcd_barrier_post((unsigned*)(F.ctl + CW_BAR), F.MISC + 8);
    const int lo = args.ph_lo, hi = args.ph_hi;
    int ph = 0;
#define IN(k) (lo <= (k) && (k) < hi)
#define PHASE_LANE() int pm1 = -1; asm volatile("" : "+s"(pm1)); int ptid = F.wave * 64 + (int)__builtin_amdgcn_mbcnt_hi((unsigned)pm1, __builtin_amdgcn_mbcnt_lo((unsigned)pm1, 0u)); asm volatile("" : "+v"(ptid)); const int plane = ptid & 63; (void)plane
#define SEAM(k) do { if (IN(k) && IN((k) + 1)) xcd_barrier(bar); } while (0)
    const int gw = F.vcu * NWAVES + F.wave, NGW = F.G * NWAVES;
    bf16* XB = (bf16*)(ws + WS_XB); float* XF = (float*)(ws + WS_XF); float* V = (float*)(ws + WS_V); bf16* H = (bf16*)(ws + WS_H);
    bf16* U = (bf16*)(ws + WS_U); bf16* GB = (bf16*)(ws + WS_GB); bf16* Y = (bf16*)(ws + WS_Y); bf16* YG = (bf16*)(ws + WS_YG); bf16* YZ = (bf16*)(ws + WS_YZ);

    if (P_PRO && IN(ph)) {
        PHASE_LANE();
        LAS float* scr = (LAS float*)(F.lds + RING_OFF + F.wave * 16384);
        for (int l = 0; l < DEPTH; ++l) {
            unsigned char* wl = ws + WS_W + (size_t)l * SZ_LAYER;
            transpose_matrix(args.in[opq(1)] + (size_t)l * DM * DFF, DM, DFF, (bf16*)(wl + OFF_WGU1), 1, scr, gw, NGW, plane);
            transpose_matrix(args.in[opq(2)] + (size_t)l * DM * DFF, DM, DFF, (bf16*)(wl + OFF_WGU1), 2, scr, gw, NGW, plane);
            transpose_matrix(args.in[opq(3)] + (size_t)l * DFF * DM, DFF, DM, (bf16*)(wl + OFF_WD1), 0, scr, gw, NGW, plane);
            transpose_matrix(args.in[opq(23)] + (size_t)l * DM * DFF, DM, DFF, (bf16*)(wl + OFF_WGU2), 1, scr, gw, NGW, plane);
            transpose_matrix(args.in[opq(24)] + (size_t)l * DM * DFF, DM, DFF, (bf16*)(wl + OFF_WGU2), 2, scr, gw, NGW, plane);
            transpose_matrix(args.in[opq(25)] + (size_t)l * DFF * DM, DFF, DM, (bf16*)(wl + OFF_WD2), 0, scr, gw, NGW, plane);
            transpose_matrix(args.in[opq(6)] + (size_t)l * DM * DIN, DM, DIN, (bf16*)(wl + OFF_WIN), 0, scr, gw, NGW, plane);
            transpose_matrix(args.in[opq(15)] + (size_t)l * DS5 * DS5, DS5, DS5, (bf16*)(wl + OFF_WGLU), 0, scr, gw, NGW, plane);
            transpose_matrix(args.in[opq(20)] + (size_t)l * DM * DM, DM, DM, (bf16*)(wl + OFF_WOUT), 0, scr, gw, NGW, plane);
        }
        const size_t n8 = (size_t)M * DM / 8;
        for (size_t i = (size_t)blockIdx.x * (NWAVES * 64) + ptid; i < n8; i += (size_t)F.G * NWAVES * 64) {
            const f32x4 a = ((const GAS f32x4*)args.in[opq(0)])[2 * i], b = ((const GAS f32x4*)args.in[opq(0)])[2 * i + 1];
            v4u o; o.x = pk2(a.x, a.y); o.y = pk2(a.z, a.w); o.z = pk2(b.x, b.y); o.w = pk2(b.z, b.w);
            ((GAS v4u*)XB)[i] = o;
        }
    }
    SEAM(ph); ++ph;

    for (int fi = 0; fi < 2 * DEPTH; ++fi) {
        const int layer = fi >> 1, second = fi & 1;
        unsigned char* wl = ws + WS_W + (size_t)layer * SZ_LAYER;
        if (P_G1 && IN(ph)) {
            pg8::Gemm g{XB, (const bf16*)(wl + (second ? OFF_WGU2 : OFF_WGU1)), M, 2 * DFF, DM}; pg8::StaticOrder S; S.init(M, 2 * DFF, F.G, (int)blockIdx.x);
            pg8::EpiSwiglu E{H, DFF};
            pg8::gemm_phase<pg8::EpiSwiglu, pg8::StaticOrder, true, true>(F.lds + RING_OFF, g, S, E, F.wave);
        }
        SEAM(ph); ++ph;
        if (P_G2 && IN(ph)) {
            const float* R = (fi == 0) ? args.in[opq(0)] : XF;
            pg8::Gemm g{H, (const bf16*)(wl + (second ? OFF_WD2 : OFF_WD1)), M, DM, DFF}; pg8::StaticOrder S; S.init(M, DM, F.G, (int)blockIdx.x);
            pg8::EpiResF32 E{R, V, DM, DN_ALPHA, 0.5f};
            pg8::gemm_phase<pg8::EpiResF32, pg8::StaticOrder, true, true>(F.lds + RING_OFF, g, S, E, F.wave);
        }
        SEAM(ph); ++ph;
        if (P_LN && IN(ph)) {
            PHASE_LANE();
            const float* g = args.in[opq(second ? 26 : 4)] + (size_t)layer * DM; const float* b = args.in[opq(second ? 27 : 5)] + (size_t)layer * DM;
            float* xo = (fi == 2 * DEPTH - 1) ? args.out : XF;
            for (int m = gw; m < M; m += NGW) ln_row(V + (size_t)m * DM, g, b, xo + (size_t)m * DM, XB + (size_t)m * DM, plane);
        }
        SEAM(ph); ++ph;
        if (second) continue;
        if (P_G3 && IN(ph)) {
            pg8::Gemm g{XB, (const bf16*)(wl + OFF_WIN), M, DIN, DM}; pg8::StaticOrder S; S.init(M, DIN, F.G, (int)blockIdx.x);
            pg8::EpiProj E{U, GB};
            pg8::gemm_phase<pg8::EpiProj, pg8::StaticOrder, true, true>(F.lds + RING_OFF, g, S, E, F.wave);
        }
        SEAM(ph); ++ph;
        if (P_S5 && IN(ph)) {
            PHASE_LANE();
            #if S5_NAIVE
            for (int unit = F.vcu; unit < BATCH * S5G; unit += F.G) s5_naive_unit(F, args, layer, unit / S5G, unit % S5G, U, Y, ptid);
#else
            for (int unit = F.vcu; unit < BATCH * S5G; unit += F.G) s5f::unit(F.lds + RING_OFF, args, layer, unit / S5G, unit % S5G, U, Y, ptid, F.wave);
#endif
            conv_rows(args, layer, GB, YZ, gw, NGW, plane);
        }
        SEAM(ph); ++ph;
        if (P_G4 && IN(ph)) {
            pg8::Gemm g{Y, (const bf16*)(wl + OFF_WGLU), M, DS5, DS5}; pg8::StaticOrder S; S.init(M, DS5, F.G, (int)blockIdx.x);
            pg8::EpiGlu E{Y, YG, DS5};
            pg8::gemm_phase<pg8::EpiGlu, pg8::StaticOrder, true, true>(F.lds + RING_OFF, g, S, E, F.wave);
        }
        SEAM(ph); ++ph;
        if (P_YN && IN(ph)) { PHASE_LANE(); ynorm_rows(args, layer, YG, YZ, gw, NGW, plane); }
        SEAM(ph); ++ph;
        if (P_G5 && IN(ph)) {
            pg8::Gemm g{YZ, (const bf16*)(wl + OFF_WOUT), M, DM, DM}; pg8::StaticOrder S; S.init(M, DM, F.G, (int)blockIdx.x);
            pg8::EpiResF32 E{XF, V, DM, DN_ALPHA, 1.0f};
            pg8::gemm_phase<pg8::EpiResF32, pg8::StaticOrder, true, true>(F.lds + RING_OFF, g, S, E, F.wave);
        }
        SEAM(ph); ++ph;
        if (P_LN2 && IN(ph)) {
            PHASE_LANE();
            const float* g = args.in[opq(21)] + (size_t)layer * DM; const float* b = args.in[opq(22)] + (size_t)layer * DM;
            for (int m = gw; m < M; m += NGW) ln_row(V + (size_t)m * DM, g, b, XF + (size_t)m * DM, XB + (size_t)m * DM, plane);
        }
        SEAM(ph); ++ph;
    }
#undef IN
#undef SEAM
}

extern "C" void kernel_launch(void* const* d_in, const int* in_sizes, int n_in, void* d_out, int out_size, void* d_ws, size_t ws_size, hipStream_t stream) {
    static int grid = 0;
    if (grid == 0) {
        if (n_in != 28 || in_sizes[0] != M * DM || out_size != M * DM || ws_size < WS_END) { fprintf(stderr, "kernel_launch: unexpected shapes (n_in %d, in0 %d, out %d, ws %zu < %zu); nothing launched\n", n_in, n_in > 0 ? in_sizes[0] : -1, out_size, ws_size, (size_t)WS_END); grid = -1; return; }
        int dev = 0, cus = 0, per_cu = 0;
        if (hipGetDevice(&dev) != hipSuccess || hipDeviceGetAttribute(&cus, hipDeviceAttributeMultiprocessorCount, dev) != hipSuccess) { grid = -1; return; }
        if (hipFuncSetAttribute((const void*)fwd, hipFuncAttributeMaxDynamicSharedMemorySize, LDS_BYTES) != hipSuccess) { fprintf(stderr, "kernel_launch: hipFuncSetAttribute failed\n"); grid = -1; return; }
        if (hipOccupancyMaxActiveBlocksPerMultiprocessor(&per_cu, (const void*)fwd, NWAVES * 64, LDS_BYTES) != hipSuccess || per_cu < 1) fprintf(stderr, "kernel_launch: occupancy query reports %d\n", per_cu);
        (void)hipGetLastError();
        grid = cus;
    }
    if (grid < 0) return;
    if (hipMemsetAsync((char*)d_ws + WS_CTL, 0, CTL_ZERO_BYTES, stream) != hipSuccess) return;
    Args a{};
    for (int i = 0; i < 28; ++i) a.in[i] = (const float*)d_in[i];
    a.out = (float*)d_out; a.ws = (unsigned char*)d_ws; a.pad = 0;
#if MK_PER_PHASE
    for (int k = 0; k < NPHASE; ++k) { a.ph_lo = k; a.ph_hi = k + 1; a.use_bar = 0; hipLaunchKernelGGL(fwd, dim3(grid), dim3(NWAVES * 64), LDS_BYTES, stream, a); }
#else
    a.ph_lo = 0; a.ph_hi = NPHASE; a.use_bar = 1;
    hipLaunchKernelGGL(fwd, dim3(grid), dim3(NWAVES * 64), LDS_BYTES, stream, a);
#endif
    const hipError_t le = hipPeekAtLastError();
    if (le != hipSuccess) fprintf(stderr, "kernel_launch: launch failed: %s\n", hipGetErrorName(le));
}
```
